# Optimizing an MI355X kernel written in HIP

```python
import jax, jax.numpy as jnp
from jax import lax
import numpy as np

D_MODEL = 1024
BATCH = 2
SEQ = 8192
DEPTH = 2

GRID_W = 64
CTX_LEN = 256

RET_W = D_MODEL // 2
RET_HEADS = 4
RET_HEAD_DIM = RET_W // RET_HEADS
RET_CHUNK = 128
ROPE_BASE = 10000.0
ROPE_FREQS = RET_HEAD_DIM // 4
FNET_W = D_MODEL // 4
FNET_GROUPS = 4
FNET_GROUP_DIM = FNET_W // FNET_GROUPS
GMLP_W = D_MODEL // 4
GMLP_GROUPS = 4
GMLP_GROUP_DIM = GMLP_W // GMLP_GROUPS
GMLP_CHUNK = 128
N_BRANCH = 3
D_FF = 4 * D_MODEL
EPS = 1e-6
IN_W = 4 * RET_W + FNET_W + 2 * GMLP_W + N_BRANCH * D_MODEL
IN_SPLITS = (RET_W, 2 * RET_W, 3 * RET_W, 4 * RET_W, 4 * RET_W + FNET_W,
             4 * RET_W + FNET_W + GMLP_W, 4 * RET_W + FNET_W + 2 * GMLP_W)

kernel_name = "hybrid_retention_fourier_sgu_prefix_dit"


def rms_norm(x, gain=None):
    xf = x.astype(jnp.float32)
    y = xf * lax.rsqrt(jnp.mean(xf * xf, axis=-1, keepdims=True) + EPS)
    if gain is not None:
        y = y * gain.astype(jnp.float32)
    return y.astype(x.dtype)


def modulate(h, shift, scale):
    return h * (1.0 + scale) + shift


def grid_rope_angles(n_tokens):
    rows = n_tokens // GRID_W
    row = jnp.repeat(jnp.arange(rows, dtype=jnp.float32), GRID_W)
    col = jnp.tile(jnp.arange(GRID_W, dtype=jnp.float32), rows)
    freqs = ROPE_BASE ** (-jnp.arange(ROPE_FREQS, dtype=jnp.float32) / ROPE_FREQS)
    return jnp.concatenate([row[:, None] * freqs, col[:, None] * freqs], axis=-1)


def apply_grid_rope(a, angles):
    cos = jnp.cos(angles)[None, :, None, :]
    sin = jnp.sin(angles)[None, :, None, :]
    a1, a2 = jnp.split(a, 2, axis=-1)
    return jnp.concatenate([a1 * cos - a2 * sin, a1 * sin + a2 * cos], axis=-1)


def ret_scan_states(k, v, log_g, s0):
    B, L, H, dk = k.shape
    n = L // RET_CHUNK
    kc = k.reshape(B, n, RET_CHUNK, H, dk)
    vc = v.reshape(B, n, RET_CHUNK, H, -1)
    pos = jnp.arange(RET_CHUNK, dtype=jnp.float32)
    w_state = jnp.exp(log_g[:, None] * (RET_CHUNK - 1.0 - pos)[None, :])
    u = jnp.einsum('bnshd,hs,bnshe->nbhde', kc, w_state, vc)
    decay = jnp.exp(log_g * RET_CHUNK)[None, :, None, None]

    def step(s, u_i):
        return decay * s + u_i, s

    s_final, s_starts = lax.scan(step, s0, u)
    return s_starts, s_final


def ret_chunk_out(q, k, v, log_g, s_starts, inclusive):
    B, L, H, dk = q.shape
    n = L // RET_CHUNK
    qc = q.reshape(B, n, RET_CHUNK, H, dk)
    kc = k.reshape(B, n, RET_CHUNK, H, dk)
    vc = v.reshape(B, n, RET_CHUNK, H, -1)
    pos = jnp.arange(RET_CHUNK, dtype=jnp.float32)
    diff = pos[:, None] - pos[None, :]
    keep = (diff >= 0) if inclusive else (diff > 0)
    dmask = jnp.where(keep[None], jnp.exp(log_g[:, None, None] * jnp.maximum(diff, 0.0)[None]), 0.0)
    scores = jnp.einsum('bnchd,bnshd->bnhcs', qc, kc) * dmask[None, None]
    inner = jnp.einsum('bnhcs,bnshe->bnche', scores, vc)
    q_decay = jnp.exp(log_g[:, None] * (pos + 1.0)[None, :])
    cross = jnp.einsum('bnchd,hc,nbhde->bnche', qc, q_decay, s_starts)
    return (inner + cross).reshape(B, L, H, -1)


def retention_bidir(q, k, v, log_g_f, log_g_b, s0_f, s0_b):
    st_f, sf = ret_scan_states(k, v, log_g_f, s0_f)
    o_f = ret_chunk_out(q, k, v, log_g_f, st_f, True)
    qr, kr, vr = jnp.flip(q, axis=1), jnp.flip(k, axis=1), jnp.flip(v, axis=1)
    st_b, sb = ret_scan_states(kr, vr, log_g_b, s0_b)
    o_b = jnp.flip(ret_chunk_out(qr, kr, vr, log_g_b, st_b, False), axis=1)
    return o_f + o_b, sf, sb


def fourier_mix(f):
    B, L, _ = f.shape
    fg = f.reshape(B, L, FNET_GROUPS, FNET_GROUP_DIM).astype(jnp.float32)
    y = jnp.fft.fft2(fg, axes=(1, 3), norm='ortho').real
    return y.reshape(B, L, FNET_W).astype(f.dtype)


def sgu_mix(u, v, w_s, b_s, g_norm):
    B, L, _ = v.shape
    u = jax.nn.gelu(u)
    v = jax.nn.gelu(v).reshape(B, L, GMLP_GROUPS, GMLP_GROUP_DIM)
    v = rms_norm(v, g_norm.reshape(GMLP_GROUPS, GMLP_GROUP_DIM))
    v = v.reshape(B, L // GMLP_CHUNK, GMLP_CHUNK, GMLP_GROUPS, GMLP_GROUP_DIM)
    s = jnp.einsum('gts,bnsgc->bntgc', w_s, v) + jnp.transpose(b_s)[None, None, :, :, None]
    return u * s.reshape(B, L, GMLP_W)


def token_mixer(h, w_in, log_g, w_s, b_s, g_norm, w_a, w_b, w_c, w_o, s0_f, s0_b, angles):
    B, L, _ = h.shape
    z = h @ w_in
    q, k, v, g, f, u, vs, gates = jnp.split(z, IN_SPLITS, axis=-1)
    q = q.reshape(B, L, RET_HEADS, RET_HEAD_DIM).astype(jnp.float32)
    k = k.reshape(B, L, RET_HEADS, RET_HEAD_DIM).astype(jnp.float32) * (RET_HEAD_DIM ** -0.5)
    v = v.reshape(B, L, RET_HEADS, RET_HEAD_DIM).astype(jnp.float32)
    if angles is not None:
        q = apply_grid_rope(q, angles)
        k = apply_grid_rope(k, angles)
    o, sf, sb = retention_bidir(q, k, v, log_g[0], log_g[1], s0_f, s0_b)
    ret = rms_norm(o).reshape(B, L, RET_W).astype(h.dtype) * jax.nn.silu(g)
    four = fourier_mix(f)
    sgu = sgu_mix(u, vs, w_s, b_s, g_norm)
    ga, gb, gc = jnp.split(jax.nn.sigmoid(gates), N_BRANCH, axis=-1)
    merged = ga * (ret @ w_a) + gb * (four @ w_b) + gc * (sgu @ w_c)
    return merged @ w_o, sf, sb


def sq_relu_mlp(h, w_up, w_down):
    a = jax.nn.relu(h @ w_up)
    return (a * a) @ w_down


def setup_inputs(seed: int = 0) -> dict:
    key = jax.random.key(seed)
    ks = jax.random.split(key, 24)
    f32 = jnp.float32
    nrm = lambda k, shape, s: jax.random.normal(k, shape, f32) * s
    base_logit = jnp.log(2.0 ** (5.0 + jnp.arange(RET_HEADS, dtype=f32)) - 1.0)
    return {
        'x': nrm(ks[0], (BATCH, SEQ, D_MODEL), 1.0),
        'c': nrm(ks[1], (BATCH, D_MODEL), 1.0),
        'ctx': nrm(ks[2], (BATCH, CTX_LEN, D_MODEL), 1.0),
        'c_ctx': nrm(ks[3], (D_MODEL,), 1.0),
        'w_mod': nrm(ks[4], (DEPTH, D_MODEL, 6 * D_MODEL), 0.5 * D_MODEL ** -0.5),
        'b_mod': nrm(ks[5], (DEPTH, 6 * D_MODEL), 0.02),
        'g_pre_mix': 1.0 + nrm(ks[6], (DEPTH, D_MODEL), 0.02),
        'g_post_mix': 1.0 + nrm(ks[7], (DEPTH, D_MODEL), 0.02),
        'g_pre_mlp': 1.0 + nrm(ks[8], (DEPTH, D_MODEL), 0.02),
        'g_post_mlp': 1.0 + nrm(ks[9], (DEPTH, D_MODEL), 0.02),
        'w_in': nrm(ks[10], (DEPTH, D_MODEL, IN_W), D_MODEL ** -0.5),
        'ret_decay_logit': base_logit[None, None, :] + nrm(ks[11], (DEPTH, 2, RET_HEADS), 0.1),
        'sgu_w_s': nrm(ks[12], (DEPTH, GMLP_GROUPS, GMLP_CHUNK, GMLP_CHUNK), GMLP_CHUNK ** -0.5),
        'sgu_b_s': 1.0 + nrm(ks[13], (DEPTH, GMLP_GROUPS, GMLP_CHUNK), 0.02),
        'sgu_norm': 1.0 + nrm(ks[14], (DEPTH, GMLP_W), 0.02),
        'w_branch_a': nrm(ks[15], (DEPTH, RET_W, D_MODEL), RET_W ** -0.5),
        'w_branch_b': nrm(ks[16], (DEPTH, FNET_W, D_MODEL), FNET_W ** -0.5),
        'w_branch_c': nrm(ks[17], (DEPTH, GMLP_W, D_MODEL), GMLP_W ** -0.5),
        'w_out': nrm(ks[18], (DEPTH, D_MODEL, D_MODEL), D_MODEL ** -0.5),
        'w_up': nrm(ks[19], (DEPTH, D_MODEL, D_FF), D_MODEL ** -0.5),
        'w_down': nrm(ks[20], (DEPTH, D_FF, D_MODEL), D_FF ** -0.5),
    }


def reference(x, c, ctx, c_ctx, w_mod, b_mod, g_pre_mix, g_post_mix, g_pre_mlp, g_post_mlp,
              w_in, ret_decay_logit, sgu_w_s, sgu_b_s, sgu_norm, w_branch_a, w_branch_b,
              w_branch_c, w_out, w_up, w_down):
    B, L, _ = x.shape
    angles = grid_rope_angles(L)
    silu_c = jax.nn.silu(c)
    silu_cc = jax.nn.silu(c_ctx)
    s0 = jnp.zeros((B, RET_HEADS, RET_HEAD_DIM, RET_HEAD_DIM), jnp.float32)
    for l in range(DEPTH):
        last = l == DEPTH - 1
        mod = (silu_c @ w_mod[l] + b_mod[l])[:, None, :]
        sh1, sc1, gt1, sh2, sc2, gt2 = jnp.split(mod, 6, axis=-1)
        mod_c = silu_cc @ w_mod[l] + b_mod[l]
        csh1, csc1, cgt1, csh2, csc2, cgt2 = jnp.split(mod_c, 6, axis=-1)
        log_g = jax.nn.log_sigmoid(ret_decay_logit[l].astype(jnp.float32))

        hc = modulate(rms_norm(ctx, g_pre_mix[l]), csh1, csc1)
        if last:
            kc_, vc_ = jnp.split(hc @ w_in[l][:, RET_W:3 * RET_W], 2, axis=-1)
            kc_ = kc_.reshape(B, CTX_LEN, RET_HEADS, RET_HEAD_DIM).astype(jnp.float32) * (RET_HEAD_DIM ** -0.5)
            vc_ = vc_.reshape(B, CTX_LEN, RET_HEADS, RET_HEAD_DIM).astype(jnp.float32)
            _, sf = ret_scan_states(kc_, vc_, log_g[0], s0)
            _, sb = ret_scan_states(jnp.flip(kc_, axis=1), jnp.flip(vc_, axis=1), log_g[1], s0)
        else:
            yc, sf, sb = token_mixer(hc, w_in[l], log_g, sgu_w_s[l], sgu_b_s[l], sgu_norm[l],
                                     w_branch_a[l], w_branch_b[l], w_branch_c[l], w_out[l],
                                     s0, s0, None)
            ctx_mid = ctx + cgt1 * rms_norm(yc, g_post_mix[l])
            hc2 = modulate(rms_norm(ctx_mid, g_pre_mlp[l]), csh2, csc2)
            ctx_next = ctx_mid + cgt2 * rms_norm(sq_relu_mlp(hc2, w_up[l], w_down[l]), g_post_mlp[l])

        h = modulate(rms_norm(x, g_pre_mix[l]), sh1, sc1)
        y, _, _ = token_mixer(h, w_in[l], log_g, sgu_w_s[l], sgu_b_s[l], sgu_norm[l],
                              w_branch_a[l], w_branch_b[l], w_branch_c[l], w_out[l],
                              sf, sb, angles)
        x = x + gt1 * rms_norm(y, g_post_mix[l])
        h2 = modulate(rms_norm(x, g_pre_mlp[l]), sh2, sc2)
        x = x + gt2 * rms_norm(sq_relu_mlp(h2, w_up[l], w_down[l]), g_post_mlp[l])

        if not last:
            ctx = ctx_next
    return x
```

```cpp
#include <hip/hip_runtime.h>
#include <hip/hip_cooperative_groups.h>
#include <cstdio>
#include <cstdint>
namespace cg = cooperative_groups;

#define LAS __attribute__((address_space(3)))
typedef unsigned short bf16_t;
typedef short bf16x8 __attribute__((ext_vector_type(8)));
typedef float f32x4 __attribute__((ext_vector_type(4)));
typedef unsigned u32x4 __attribute__((ext_vector_type(4)));
typedef unsigned u32x2 __attribute__((ext_vector_type(2)));

constexpr int D = 1024, SEQ = 8192, NB = 2, ML = NB * SEQ, CTXL = 256, MC = NB * CTXL, MT = ML + MC;
constexpr int INW = 5888, N1W = 2816, NGW = 3072, FF = 4096;
constexpr int QKVW = 1536, ZBW = 1280;
constexpr int NCH = MT / 128;
constexpr float EPS = 1e-6f;
constexpr int NTHR = 512, NWAVES = 8;
constexpr int LDS_BYTES = 147456;

constexpr size_t WS_MOD = 65536;
constexpr size_t WS_CTXS = 262144;
constexpr size_t WS_W = 2359296;
constexpr size_t WL_IN = 0, WL_CAT = (size_t)INW * D, WL_O = WL_CAT + (size_t)D * D, WL_UP = WL_O + (size_t)D * D, WL_DN = WL_UP + (size_t)FF * D, WL_EL = WL_DN + (size_t)FF * D;
constexpr size_t WS_HN = WS_W + 2 * WL_EL * 2;
constexpr size_t WS_ZB = WS_HN + (size_t)MT * D * 2;
constexpr size_t WS_BIG = WS_ZB + (size_t)MT * ZBW * 2;
constexpr size_t BIG_QKV = 0, BIG_SU = (size_t)MT * QKVW * 2, BIG_T = BIG_SU + (size_t)2 * NCH * 4 * 16384 * 2;
constexpr size_t WS_END = WS_BIG + (size_t)MT * NGW * 2;
static_assert(BIG_T + (size_t)2 * 4 * 128 * 64 * 128 * 2 <= (size_t)MT * NGW * 2, "BIG region");
static_assert(WS_END <= 268435456, "workspace");
static_assert((size_t)MT * FF * 2 <= WS_END - WS_ZB, "HID overlay");

__device__ __forceinline__ float bflo(unsigned w) { return __uint_as_float(w << 16); }
__device__ __forceinline__ float bfhi(unsigned w) { return __uint_as_float(w & 0xffff0000u); }
__device__ __forceinline__ float bf1(bf16_t v) { return __uint_as_float((unsigned)v << 16); }
typedef float f32x2_t __attribute__((ext_vector_type(2))); typedef __bf16 bf16x2_t __attribute__((ext_vector_type(2)));
__device__ __forceinline__ unsigned pk2(float lo, float hi) { f32x2_t v = {lo, hi}; bf16x2_t b = __builtin_convertvector(v, bf16x2_t); return __builtin_bit_cast(unsigned, b); }
__device__ __forceinline__ bf16_t f2bf(float f) { return (bf16_t)(pk2(f, 0.f) & 0xffffu); }
__device__ __forceinline__ float wave_sum(float v) {
#pragma unroll
    for (int o = 1; o < 64; o <<= 1) v += __shfl_xor(v, o);
    return v;
}
__device__ __forceinline__ f32x4 mfma16(bf16x8 x, bf16x8 y, f32x4 acc) { return __builtin_amdgcn_mfma_f32_16x16x32_bf16(x, y, acc, 0, 0, 0); }
__device__ __forceinline__ bf16x8 lfrag(const LAS bf16_t* base, int row, int stride, int col) { return *(const LAS bf16x8*)(base + row * stride + col); }
__device__ __forceinline__ bf16x8 gfrag(const bf16_t* p) { return *(const bf16x8*)p; }
__device__ __forceinline__ float cos_rev(float r) { return __builtin_amdgcn_cosf(r); }
__device__ __forceinline__ float sin_rev(float r) { return __builtin_amdgcn_sinf(r); }
__device__ __forceinline__ float logsig(float x) { return -log1pf(expf(-x)); }
__device__ __forceinline__ float act_f(float v, int act) {
    if (act == 0) return v;
    if (act == 4) { const float r = fmaxf(v, 0.f); return r * r; }
    const float u = (act == 2) ? 1.5957691216057308f * (v + 0.044715f * v * v * v) : v;
    const float s = __builtin_amdgcn_rcpf(1.f + __expf(-u));
    return act == 3 ? s : v * s;
}


#define XB_TMO      128
#define XB_XCNT(j)  (256  + 64 * (j))
#define XB_XSUB(j)  (1280 + 64 * (j))
#define XB_XGEN(j)  (2304 + 64 * (j))
#define XB_TOP      3328
#define XB_TOPGEN   3392
#define XCD_BAR_WORDS 3456
#define XB_SPIN_CAP (1u << 18)
__device__ __forceinline__ unsigned xb_ld(unsigned* p)              { return __hip_atomic_load(p, __ATOMIC_RELAXED, __HIP_MEMORY_SCOPE_AGENT); }
__device__ __forceinline__ unsigned xb_add(unsigned* p, unsigned v) { return __hip_atomic_fetch_add(p, v, __ATOMIC_RELAXED, __HIP_MEMORY_SCOPE_AGENT); }
__device__ __forceinline__ unsigned xb_xcc_id() { return (unsigned)__builtin_amdgcn_s_getreg((3 << 11) | 20) & 0xFu; }
#define XB_SPIN(cond, bar) do { unsigned _sp = 0; while (cond) { __builtin_amdgcn_s_sleep(1); \
    if ((++_sp & 255u) == 0u) { if (xb_ld(&(bar)[XB_TMO])) break; if (_sp > XB_SPIN_CAP) { atomicAdd(&(bar)[XB_TMO], 1u); break; } } } } while (0)
struct XcdBarrier { unsigned* bar; unsigned x; volatile LAS unsigned* st; };
__device__ __forceinline__ XcdBarrier xcd_barrier_post(unsigned* bar, volatile LAS unsigned* st) {
    XcdBarrier b; b.bar = bar; b.x = xb_xcc_id(); b.st = st;
    if (threadIdx.x == 0) (void)xb_add(&bar[XB_XCNT(b.x)], 1u);
    return b;
}
__device__ __forceinline__ void xcd_barrier_complete(unsigned* bar, unsigned x, unsigned& nloc, unsigned& nx) {
    const unsigned G = gridDim.x * gridDim.y * gridDim.z;
    unsigned sum, cnt, mine, sp = 0u;
    for (;;) {
        sum = 0u; cnt = 0u; mine = 0u;
#pragma unroll
        for (unsigned j = 0; j < 16; ++j) { const unsigned c = xb_ld(&bar[XB_XCNT(j)]); sum += c; cnt += (c > 0u) ? 1u : 0u; mine = (j == x) ? c : mine; }
        if (sum == G) break;
        __builtin_amdgcn_s_sleep(1);
        if ((++sp & 255u) == 0u) { if (xb_ld(&bar[XB_TMO])) break; if (sp > XB_SPIN_CAP) { atomicAdd(&bar[XB_TMO], 1u); break; } }
    }
    nloc = mine > 0u ? mine : 1u; nx = cnt > 0u ? cnt : 1u;
}
__device__ __forceinline__ void xcd_barrier(const XcdBarrier& b) {
    asm volatile("s_waitcnt vmcnt(0)" ::: "memory");
    __syncthreads();
    if (threadIdx.x == 0) {
        unsigned* bar = b.bar;
        __builtin_amdgcn_s_waitcnt(0);
        unsigned nloc = b.st[0], nx = b.st[1];
        if (nloc == 0u) { xcd_barrier_complete(bar, b.x, nloc, nx); b.st[0] = nloc; b.st[1] = nx; }
        const unsigned old = xb_add(&bar[XB_XSUB(b.x)], 1u);
        const unsigned gen = old / nloc;
        if (old + 1u == (gen + 1u) * nloc) {
            __builtin_amdgcn_fence(__ATOMIC_RELEASE, "agent");
            asm volatile("s_waitcnt vmcnt(0)" ::: "memory");
            const unsigned og = xb_add(&bar[XB_TOP], 1u);
            const unsigned tg = og / nx;
            if (og + 1u == (tg + 1u) * nx) xb_add(&bar[XB_TOPGEN], 1u);
            else XB_SPIN(xb_ld(&bar[XB_TOPGEN]) == tg, bar);
            __builtin_amdgcn_fence(__ATOMIC_ACQUIRE, "agent");
            xb_add(&bar[XB_XGEN(b.x)], 1u);
            asm volatile("s_waitcnt vmcnt(0)" ::: "memory");
        } else {
            XB_SPIN(xb_ld(&bar[XB_XGEN(b.x)]) == gen, bar);
            __builtin_amdgcn_fence(__ATOMIC_ACQUIRE, "agent");
            asm volatile("s_waitcnt vmcnt(0)" ::: "memory");
        }
    }
    __syncthreads();
}

namespace pg8 {
constexpr int BM = 256, BK = 64, HALF = 128, HTB = HALF * BK * 2, NXCD = 8, WGM = 8;
__host__ __device__ __forceinline__ int lds_byte(int r, int c) { const int st = (r >> 4) * 2 + (c >> 5), rr = r & 15, cc = c & 31, ob = rr * 64 + cc * 2; return st * 1024 + (ob ^ (((ob >> 9) & 1) << 5)); }
__host__ __device__ __forceinline__ void stage_rc(int b, int& R, int& C) { const int st = b / 1024, sb = b % 1024, swz = sb ^ (((sb >> 9) & 1) << 5); R = (st >> 1) * 16 + swz / 64; C = (st & 1) * 32 + (swz % 64) / 2; }
__host__ __device__ __forceinline__ int perm32(int rho) { const int n = rho >> 4, i = rho & 15; return 8 * (i >> 2) + 4 * n + (i & 3); }
struct Unit { int pm, pn; };
struct Gemm { const bf16_t* A; const bf16_t* Bt; int M, N, K, lda; };
struct StaticOrder {
    int nM, nN, nwg, G, c;
    __device__ void init(int M, int N, int G_, int c_) { nM = M / BM; nN = N / BM; nwg = nM * nN; G = G_; c = c_; }
    __device__ bool next(int i, Unit& u) const {
        const long L = (long)i * G + c; if (L >= nwg) return false;
        int wgid = (int)L; { const int q = nwg / NXCD, r = nwg % NXCD, xcd = wgid % NXCD, off = wgid / NXCD; wgid = (xcd < r ? xcd * (q + 1) : r * (q + 1) + (xcd - r) * q) + off; }
        const int nig = WGM * nN, gid = wgid / nig, fm = gid * WGM, gsz = (nM - fm) < WGM ? (nM - fm) : WGM;
        u.pm = fm + ((wgid % nig) % gsz); u.pn = (wgid % nig) / gsz; return true;
    }
};
__device__ __forceinline__ void store_tile(const f32x4 (&acc)[2][2][4][2], bf16_t* base, int ldc, int rowt, int colt, int act, float sc, int wr, int wc, int fr, int fq) {
    const int row0 = rowt + wr * 64 + fr, col0 = colt + wc * 32 + 8 * fq;
#pragma unroll
    for (int ai = 0; ai < 2; ++ai)
#pragma unroll
        for (int m = 0; m < 4; ++m) { bf16_t* rowp = base + (size_t)(row0 + ai * HALF + m * 16) * ldc + col0;
#pragma unroll
            for (int bj = 0; bj < 2; ++bj) { const f32x4 v0 = acc[ai][bj][m][0] * sc, v1 = acc[ai][bj][m][1] * sc;
                u32x4 w; w.x = pk2(act_f(v0[0], act), act_f(v0[1], act)); w.y = pk2(act_f(v0[2], act), act_f(v0[3], act));
                w.z = pk2(act_f(v1[0], act), act_f(v1[1], act)); w.w = pk2(act_f(v1[2], act), act_f(v1[3], act));
                *(u32x4*)(rowp + bj * HALF) = w; } }
}
struct EpiZ1 {
    static constexpr bool PERM = true, HAS_MID = false;
    bf16_t* qkv; bf16_t* zb;
    __device__ __forceinline__ void mid(f32x4 (&)[2][2][4][2], const Unit&, int, int, int, int, int) const {}
    __device__ __forceinline__ void operator()(const f32x4 (&acc)[2][2][4][2], const Unit& u, int wr, int wc, int fr, int fq) const {
        const int pn = u.pn; bf16_t* base; int ldc, colt, act; float sc = 1.f;
        if (pn < 6) { base = qkv; ldc = QKVW; colt = pn * 256; act = 0; if (pn == 2 || pn == 3) sc = 0.08838834764831845f; }
        else { base = zb; ldc = ZBW; colt = (pn - 6) * 256; act = (pn < 8) ? 1 : (pn == 8 ? 0 : 2); }
        store_tile(acc, base, ldc, u.pm * BM, colt, act, sc, wr, wc, fr, fq);
    }
};
struct EpiAct {
    static constexpr bool PERM = true, HAS_MID = false;
    bf16_t* O; int ldc; int act;
    __device__ __forceinline__ void mid(f32x4 (&)[2][2][4][2], const Unit&, int, int, int, int, int) const {}
    __device__ __forceinline__ void operator()(const f32x4 (&acc)[2][2][4][2], const Unit& u, int wr, int wc, int fr, int fq) const {
        store_tile(acc, O, ldc, u.pm * BM, u.pn * BM, act, 1.f, wr, wc, fr, fq);
    }
};
struct EpiGate {
    static constexpr bool PERM = true, HAS_MID = true;
    const bf16_t* gates; bf16_t* O;
    __device__ __forceinline__ void mid(f32x4 (&acc)[2][2][4][2], const Unit& u, int t, int wr, int wc, int fr, int fq) const {
        const int numofs = (t == 8) ? 0 : 1024;
#pragma unroll
        for (int ai = 0; ai < 2; ++ai)
#pragma unroll
            for (int m = 0; m < 4; ++m) { const bf16_t* gp = gates + (size_t)(u.pm * BM + ai * HALF + wr * 64 + m * 16 + fr) * NGW + u.pn * BM + wc * 32 + 8 * fq + numofs;
#pragma unroll
                for (int bj = 0; bj < 2; ++bj) { const u32x4 nv = *(const u32x4*)(gp + bj * HALF), dv = *(const u32x4*)(gp + bj * HALF + 1024);
#pragma unroll
                    for (int e = 0; e < 4; ++e) { const float n0 = bflo(nv[e]), n1 = bfhi(nv[e]), d0 = bflo(dv[e]), d1 = bfhi(dv[e]);
                        acc[ai][bj][m][e >> 1][(e & 1) * 2] *= n0 * __builtin_amdgcn_rcpf(d0); acc[ai][bj][m][e >> 1][(e & 1) * 2 + 1] *= n1 * __builtin_amdgcn_rcpf(d1); } }
                asm volatile("" ::: "memory"); }
    }
    __device__ __forceinline__ void operator()(const f32x4 (&acc)[2][2][4][2], const Unit& u, int wr, int wc, int fr, int fq) const {
        const int row0 = u.pm * BM + wr * 64 + fr, col0 = u.pn * BM + wc * 32 + 8 * fq;
#pragma unroll
        for (int ai = 0; ai < 2; ++ai)
#pragma unroll
            for (int m = 0; m < 4; ++m) { const size_t r = (size_t)(row0 + ai * HALF + m * 16);
#pragma unroll
                for (int bj = 0; bj < 2; ++bj) { const u32x4 gv = *(const u32x4*)(gates + r * NGW + col0 + bj * HALF + 2048);
                    const f32x4 v0 = acc[ai][bj][m][0], v1 = acc[ai][bj][m][1];
                    u32x4 w; w.x = pk2(v0[0] * bflo(gv[0]), v0[1] * bfhi(gv[0])); w.y = pk2(v0[2] * bflo(gv[1]), v0[3] * bfhi(gv[1]));
                    w.z = pk2(v1[0] * bflo(gv[2]), v1[1] * bfhi(gv[2])); w.w = pk2(v1[2] * bflo(gv[3]), v1[3] * bfhi(gv[3]));
                    *(u32x4*)(O + r * D + col0 + bj * HALF) = w; } }
    }
};

template <class Epi>
__device__ __forceinline__ void gemm_phase(LAS unsigned char* lds, const Gemm g, const StaticOrder& S, const Epi& E) {
    int tid = threadIdx.x; asm volatile("" : "+v"(tid));
    const int wid = __builtin_amdgcn_readfirstlane(tid >> 6), lane = tid & 63, wr = wid >> 2, wc = wid & 3, fr = lane & 15, fq = lane >> 4;
    const int K = g.K, nt = K / BK, lda = g.lda;
    unsigned voffA, voffB;
    { int R, C; stage_rc(tid * 16, R, C); const int Rb = Epi::PERM ? ((R & ~31) + perm32(R & 31)) : R;
        voffA = (unsigned)(R * lda + C) * 2u; voffB = (unsigned)(Rb * K + C) * 2u; }
    const size_t sk_voffA = (size_t)64 * lda * 2, sk_voffB = (size_t)64 * K * 2;
    const size_t kstep = (size_t)(BK * 2);
    const size_t hsA = (size_t)HALF * lda * 2, hsB = (size_t)HALF * K * 2, tsA = 2 * hsA, tsB = 2 * hsB;
    const unsigned ldsw = (unsigned)wid * 1024u;
    const int aoff = lds_byte(wr * 64 + fr, fq * 8), boff = lds_byte(wc * 32 + fr, fq * 8);
#define PG8_SA(b, h) (((b) * 2 + (h)) * HTB)
#define PG8_SB(b, h) ((4 + (b) * 2 + (h)) * HTB)
#define PG8_STAGE(bufoff, gbase, voff) do { _Pragma("unroll") for (int _i = 0; _i < 2; ++_i) \
        __builtin_amdgcn_global_load_lds((const unsigned*)((const char*)(gbase) + (size_t)_i * sk_##voff + (voff)), (LAS unsigned*)(lds + (bufoff) + ldsw + _i * 8192), 16, 0, 0); } while (0)
#define PG8_LDA(dst, b, h) do { _Pragma("unroll") for (int m = 0; m < 4; ++m) _Pragma("unroll") for (int k = 0; k < 2; ++k) dst[m][k] = *(const LAS bf16x8*)(lds + PG8_SA(b, h) + aoff + m * 2048 + k * 1024); } while (0)
#define PG8_LDB(dst, b, h) do { _Pragma("unroll") for (int n = 0; n < 2; ++n) _Pragma("unroll") for (int k = 0; k < 2; ++k) dst[n][k] = *(const LAS bf16x8*)(lds + PG8_SB(b, h) + boff + n * 2048 + k * 1024); } while (0)
#define PG8_MMA(ai, bj, At, Bt) do { __builtin_amdgcn_s_setprio(1); _Pragma("unroll") for (int m = 0; m < 4; ++m) _Pragma("unroll") for (int n = 0; n < 2; ++n) _Pragma("unroll") for (int k = 0; k < 2; ++k) \
        acc[ai][bj][m][n] = __builtin_amdgcn_mfma_f32_16x16x32_bf16(Bt[n][k], At[m][k], acc[ai][bj][m][n], 0, 0, 0); __builtin_amdgcn_s_setprio(0); } while (0)
#define PG8_WAIT_V(n) asm volatile("s_waitcnt vmcnt(" #n ")" ::: "memory")
#define PG8_WAIT_L(n) asm volatile("s_waitcnt lgkmcnt(" #n ")" ::: "memory")
#define PG8_BAR __builtin_amdgcn_s_barrier()
#define PG8_SCHED __builtin_amdgcn_sched_barrier(0)
    Unit cur, nxt; int ui = 0;
    if (!S.next(0, cur)) return;
    f32x4 acc[2][2][4][2];
#pragma unroll
    for (int a = 0; a < 2; ++a)
#pragma unroll
        for (int b = 0; b < 2; ++b)
#pragma unroll
            for (int m = 0; m < 4; ++m)
#pragma unroll
                for (int n = 0; n < 2; ++n) acc[a][b][m][n] = (f32x4){0.f, 0.f, 0.f, 0.f};
    bf16x8 At[4][2], B0[2][2], B1[2][2];
    const char* cA = (const char*)g.A + (size_t)cur.pm * tsA; const char* cB = (const char*)g.Bt + (size_t)cur.pn * tsB;
    PG8_STAGE(PG8_SB(0, 0), cB, voffB); PG8_STAGE(PG8_SB(0, 1), cB + hsB, voffB); PG8_STAGE(PG8_SA(0, 0), cA, voffA); PG8_STAGE(PG8_SA(0, 1), cA + hsA, voffA);
    if (wr == 1) PG8_BAR;
    PG8_WAIT_V(2); PG8_BAR;
    PG8_STAGE(PG8_SB(1, 0), cB + kstep, voffB); PG8_STAGE(PG8_SA(1, 0), cA + kstep, voffA); PG8_STAGE(PG8_SB(1, 1), cB + hsB + kstep, voffB);
    PG8_WAIT_V(6); PG8_BAR;
    for (;;) {
        const bool has_next = S.next(ui + 1, nxt);
        const char* nA = has_next ? (const char*)g.A + (size_t)nxt.pm * tsA : cA; const char* nB = has_next ? (const char*)g.Bt + (size_t)nxt.pn * tsB : cB;
        for (int t = 0; t < nt; t += 2) {
            const bool last = (t == nt - 2);
            const char* a1 = cA + (size_t)(t + 1) * kstep;
            const char* a2 = last ? nA : cA + (size_t)(t + 2) * kstep; const char* b2 = last ? nB : cB + (size_t)(t + 2) * kstep;
            const char* a3 = a2 + kstep; const char* b3 = b2 + kstep;
            if constexpr (Epi::HAS_MID) { if (t == 8 || t == 12) E.mid(acc, cur, t, wr, wc, fr, fq); }
            PG8_LDB(B0, 0, 0); PG8_LDB(B1, 0, 1); PG8_SCHED; PG8_LDA(At, 0, 0); PG8_STAGE(PG8_SA(1, 1), a1 + hsA, voffA);
            PG8_WAIT_V(8); PG8_WAIT_L(0); PG8_BAR; PG8_MMA(0, 0, At, B0); PG8_MMA(0, 1, At, B1); PG8_BAR; PG8_SCHED;
            PG8_LDA(At, 0, 1); PG8_STAGE(PG8_SB(0, 0), b2, voffB); PG8_STAGE(PG8_SB(0, 1), b2 + hsB, voffB); PG8_STAGE(PG8_SA(0, 0), a2, voffA);
            PG8_WAIT_V(8); PG8_WAIT_L(0); PG8_BAR; PG8_MMA(1, 0, At, B0); PG8_MMA(1, 1, At, B1); PG8_BAR; PG8_SCHED;
            PG8_LDB(B0, 1, 0); PG8_LDB(B1, 1, 1); PG8_SCHED; PG8_LDA(At, 1, 0); PG8_STAGE(PG8_SA(0, 1), a2 + hsA, voffA);
            PG8_WAIT_V(8); PG8_WAIT_L(0); PG8_BAR; PG8_MMA(0, 0, At, B0); PG8_MMA(0, 1, At, B1); PG8_BAR; PG8_SCHED;
            PG8_LDA(At, 1, 1); PG8_STAGE(PG8_SB(1, 0), b3, voffB); PG8_STAGE(PG8_SB(1, 1), b3 + hsB, voffB); PG8_STAGE(PG8_SA(1, 0), a3, voffA);
            PG8_WAIT_V(8); PG8_WAIT_L(0); PG8_BAR; PG8_MMA(1, 0, At, B0); PG8_MMA(1, 1, At, B1); PG8_BAR; PG8_SCHED;
        }
        if (wr == 0) PG8_BAR;
        E(acc, cur, wr, wc, fr, fq);
        if (!has_next) break;
#pragma unroll
        for (int a = 0; a < 2; ++a)
#pragma unroll
            for (int b = 0; b < 2; ++b)
#pragma unroll
                for (int m = 0; m < 4; ++m)
#pragma unroll
                    for (int n = 0; n < 2; ++n) acc[a][b][m][n] = (f32x4){0.f, 0.f, 0.f, 0.f};
        cur = nxt; cA = nA; cB = nB; ++ui;
        if (wr == 1) PG8_BAR;
    }
    PG8_WAIT_V(0);
    PG8_BAR;
#undef PG8_SA
#undef PG8_SB
#undef PG8_STAGE
#undef PG8_LDA
#undef PG8_LDB
#undef PG8_MMA
#undef PG8_WAIT_V
#undef PG8_WAIT_L
#undef PG8_BAR
#undef PG8_SCHED
}
}

__device__ __forceinline__ void tr_item(const float* W, int N, bf16_t* WT, int ldk, int kofs, LAS float* scr, int item, int lane) {
    const int nblk = N / 32, kb = item / nblk, nb = item % nblk, k0 = 64 * kb, n0 = 32 * nb;
#pragma unroll 8
    for (int i = 0; i < 32; ++i) { const int kk = 2 * i + (lane >> 5); scr[kk * 33 + (lane & 31)] = W[(size_t)(k0 + kk) * N + n0 + (lane & 31)]; }
    asm volatile("s_waitcnt lgkmcnt(0)" ::: "memory");
    const int c = lane & 7;
#pragma unroll
    for (int j = 0; j < 4; ++j) { const int n = (lane >> 3) + 8 * j; const LAS float* s = scr + (8 * c) * 33 + n;
        u32x4 o; o.x = pk2(s[0 * 33], s[1 * 33]); o.y = pk2(s[2 * 33], s[3 * 33]); o.z = pk2(s[4 * 33], s[5 * 33]); o.w = pk2(s[6 * 33], s[7 * 33]);
        *(u32x4*)(WT + (size_t)(n0 + n) * ldk + kofs + k0 + 8 * c) = o; }
    asm volatile("s_waitcnt lgkmcnt(0)" ::: "memory");
}

__device__ __forceinline__ void modnorm_store(const f32x4 (&v)[4], const float* gain, const float* sc, const float* sh, bf16_t* orow, int lane) {
    float ss = 0.f;
#pragma unroll
    for (int j = 0; j < 4; ++j) ss += (v[j].x * v[j].x + v[j].y * v[j].y) + (v[j].z * v[j].z + v[j].w * v[j].w);
    const float rstd = 1.0f / sqrtf(wave_sum(ss) * (1.f / D) + EPS);
#pragma unroll
    for (int j = 0; j < 4; ++j) { const int col = 4 * lane + 256 * j;
        const f32x4 g = *(const f32x4*)(gain + col), s1 = *(const f32x4*)(sc + col), s0 = *(const f32x4*)(sh + col);
        const f32x4 h = v[j] * rstd * g * (s1 + 1.0f) + s0;
        u32x2 w; w.x = pk2(h.x, h.y); w.y = pk2(h.z, h.w); *(u32x2*)(orow + col) = w; }
}
__device__ __forceinline__ void row_update(const bf16_t* yrow, const float* xrow, float* xdst, const float* gpost, const float* gate,
                                           const float* gpre, const float* sc, const float* sh, bf16_t* hrow, int lane) {
    f32x4 y[4], x[4]; float ss = 0.f;
#pragma unroll
    for (int j = 0; j < 4; ++j) { const int col = 4 * lane + 256 * j; const u32x2 w = *(const u32x2*)(yrow + col);
        y[j] = (f32x4){bflo(w.x), bfhi(w.x), bflo(w.y), bfhi(w.y)}; x[j] = *(const f32x4*)(xrow + col);
        ss += (y[j].x * y[j].x + y[j].y * y[j].y) + (y[j].z * y[j].z + y[j].w * y[j].w); }
    const float rstd = 1.0f / sqrtf(wave_sum(ss) * (1.f / D) + EPS);
#pragma unroll
    for (int j = 0; j < 4; ++j) { const int col = 4 * lane + 256 * j;
        const f32x4 g = *(const f32x4*)(gpost + col), gt = *(const f32x4*)(gate + col);
        x[j] = x[j] + gt * (y[j] * rstd * g);
#ifdef DBG_SANITIZE
        if (!hrow) { for (int e = 0; e < 4; ++e) if (!(fabsf(x[j][e]) < 1e30f)) x[j][e] = 12345.f; }
#endif
        *(f32x4*)(xdst + col) = x[j]; }
    if (hrow) modnorm_store(x, gpre, sc, sh, hrow, lane);
}

constexpr int LP = 136;
constexpr int LP64 = 72;
constexpr int LPC = 264;
constexpr int TBL_OFF = 106496;

__device__ __forceinline__ int chunk_row0(int ch) { return ch < 128 ? ch * 128 : ML + (ch - 128) * 128; }

__device__ __forceinline__ void unit_rb(LAS unsigned char* L, bf16_t* qkv, bf16_t* su, const float* dlog, int ch, int h, int tid) {
    asm volatile("" : "+v"(tid));
    const bool latent = ch < 128; const int r0 = chunk_row0(ch);
    const float lgf = logsig(dlog[h]), lgb = logsig(dlog[4 + h]);
    LAS bf16_t* KT = (LAS bf16_t*)L; LAS bf16_t* VfT = KT + 128 * LP; LAS bf16_t* VbT = VfT + 128 * LP;
    u32x4 gk[2][2], gq[2][2], gv[4];
#pragma unroll
    for (int it = 0; it < 2; ++it) { const int item = it * NTHR + tid, c = item & 127, d0 = (item >> 7) * 8;
        const bf16_t* rowp = qkv + (size_t)(r0 + c) * QKVW + h * 128 + d0;
        gk[it][0] = *(const u32x4*)(rowp + 512); gk[it][1] = *(const u32x4*)(rowp + 512 + 64);
        if (latent) { gq[it][0] = *(const u32x4*)(rowp); gq[it][1] = *(const u32x4*)(rowp + 64); } else { gq[it][0] = gk[it][0]; gq[it][1] = gk[it][1]; } }
#pragma unroll
    for (int it = 0; it < 4; ++it) { const int item = it * NTHR + tid; gv[it] = *(const u32x4*)(qkv + (size_t)(r0 + (item & 127)) * QKVW + 1024 + h * 128 + (item >> 7) * 8); }
#pragma unroll
    for (int it = 0; it < 2; ++it) {
        const int item = it * NTHR + tid, c = item & 127, dg = item >> 7, d0 = dg * 8;
        bf16_t* rowp = qkv + (size_t)(r0 + c) * QKVW + h * 128 + d0;
        float cs[8], sn[8];
        if (latent) { const int t = (r0 + c) & (SEQ - 1); const float pos = (dg < 4) ? (float)(t >> 6) : (float)(t & 63);
#pragma unroll
            for (int i = 0; i < 8; ++i) { const int jj = (d0 + i) & 31; float rev = pos * __builtin_amdgcn_exp2f(-(float)jj * 0.41524101186092f) * 0.15915494309189535f;
                rev = rev - floorf(rev); cs[i] = cos_rev(rev); sn[i] = sin_rev(rev); } }
        else {
#pragma unroll
            for (int i = 0; i < 8; ++i) { cs[i] = 1.f; sn[i] = 0.f; } }
        {
            const u32x4 lo = gk[it][0], hi = gk[it][1];
            u32x4 wl, wh;
#pragma unroll
            for (int e = 0; e < 4; ++e) { const float a0 = bflo(lo[e]), a1 = bfhi(lo[e]), b0 = bflo(hi[e]), b1 = bfhi(hi[e]);
                wl[e] = pk2(a0 * cs[2 * e] - b0 * sn[2 * e], a1 * cs[2 * e + 1] - b1 * sn[2 * e + 1]);
                wh[e] = pk2(a0 * sn[2 * e] + b0 * cs[2 * e], a1 * sn[2 * e + 1] + b1 * cs[2 * e + 1]); }
            if (latent) { *(u32x4*)(rowp + 512) = wl; *(u32x4*)(rowp + 512 + 64) = wh; }
#pragma unroll
            for (int e = 0; e < 4; ++e) { KT[(d0 + 2 * e) * LP + c] = (bf16_t)(wl[e] & 0xffffu); KT[(d0 + 2 * e + 1) * LP + c] = (bf16_t)(wl[e] >> 16);
                KT[(64 + d0 + 2 * e) * LP + c] = (bf16_t)(wh[e] & 0xffffu); KT[(64 + d0 + 2 * e + 1) * LP + c] = (bf16_t)(wh[e] >> 16); }
        }
        if (latent) {
            const u32x4 lo = gq[it][0], hi = gq[it][1];
            u32x4 wl, wh;
#pragma unroll
            for (int e = 0; e < 4; ++e) { const float a0 = bflo(lo[e]), a1 = bfhi(lo[e]), b0 = bflo(hi[e]), b1 = bfhi(hi[e]);
                wl[e] = pk2(a0 * cs[2 * e] - b0 * sn[2 * e], a1 * cs[2 * e + 1] - b1 * sn[2 * e + 1]);
                wh[e] = pk2(a0 * sn[2 * e] + b0 * cs[2 * e], a1 * sn[2 * e + 1] + b1 * cs[2 * e + 1]); }
            *(u32x4*)(rowp) = wl; *(u32x4*)(rowp + 64) = wh;
        }
    }
#pragma unroll
    for (int it = 0; it < 4; ++it) {
        const int item = it * NTHR + tid, c = item & 127, e0 = (item >> 7) * 8;
        const u32x4 vv = gv[it];
        const float wf = __expf(lgf * (float)(127 - c)), wb = __expf(lgb * (float)c);
#pragma unroll
        for (int e = 0; e < 4; ++e) { const float v0 = bflo(vv[e]), v1 = bfhi(vv[e]);
            VfT[(e0 + 2 * e) * LP + c] = f2bf(v0 * wf); VfT[(e0 + 2 * e + 1) * LP + c] = f2bf(v1 * wf);
            VbT[(e0 + 2 * e) * LP + c] = f2bf(v0 * wb); VbT[(e0 + 2 * e + 1) * LP + c] = f2bf(v1 * wb); }
    }
    __syncthreads();
    const int w = tid >> 6, lane = tid & 63, fr = lane & 15, fq = lane >> 4;
    bf16x8 xk[4];
#pragma unroll
    for (int kk = 0; kk < 4; ++kk) xk[kk] = lfrag(KT, 16 * w + fr, LP, kk * 32 + fq * 8);
#pragma unroll
    for (int dir = 0; dir < 2; ++dir) { const LAS bf16_t* VT = dir ? VbT : VfT;
        bf16_t* sp = su + ((size_t)(dir * NCH + ch) * 4 + h) * 16384;
#pragma unroll
        for (int et = 0; et < 8; ++et) { f32x4 a = {0.f, 0.f, 0.f, 0.f};
#pragma unroll
            for (int kk = 0; kk < 4; ++kk) a = mfma16(xk[kk], lfrag(VT, et * 16 + fr, LP, kk * 32 + fq * 8), a);
            u32x2 o; o.x = pk2(a[0], a[1]); o.y = pk2(a[2], a[3]);
            *(u32x2*)(sp + (et * 16 + fr) * 128 + 16 * w + 4 * fq) = o; } }
    __syncthreads();
}

__device__ __forceinline__ void scan_item(unsigned* su32, const float* dlog, int item, int tid) {
    asm volatile("" : "+v"(tid));
    const int combo = item >> 4, b = combo & 1, h = (combo >> 1) & 3, dir = combo >> 3, sub = item & 15;
    const int idx2 = sub * NTHR + tid;
    const float decay = expf(logsig(dlog[dir * 4 + h]) * 128.f);
    float s0 = 0.f, s1 = 0.f;
#pragma unroll 1
    for (int i0 = 0; i0 < 66; i0 += 6) {
        unsigned uv[6]; size_t off[6];
#pragma unroll
        for (int j = 0; j < 6; ++j) { const int i = i0 + j;
            const int ch = (i < 2) ? (128 + 2 * b + (dir ? 1 - i : i)) : (64 * b + (dir ? 63 - (i - 2) : (i - 2)));
            off[j] = (((size_t)(dir * NCH + ch) * 4 + h) * 16384) / 2 + idx2; uv[j] = su32[off[j]]; }
#pragma unroll
        for (int j = 0; j < 6; ++j) { su32[off[j]] = pk2(s0, s1); s0 = decay * s0 + bflo(uv[j]); s1 = decay * s1 + bfhi(uv[j]); }
    }
}

__device__ __forceinline__ void unit_rd(LAS unsigned char* L, const bf16_t* qkv, bf16_t* zb, const bf16_t* su, const float* dlog, int ch, int h, int tid) {
    asm volatile("" : "+v"(tid));
    const int r0 = chunk_row0(ch);
    const float lgf = logsig(dlog[h]), lgb = logsig(dlog[4 + h]);
    const float lgf2 = lgf * 1.4426950408889634f, lgb2 = lgb * 1.4426950408889634f;
    LAS bf16_t* Ks = (LAS bf16_t*)L; LAS bf16_t* VT = Ks + 128 * LP; LAS bf16_t* Ps = VT + 128 * LP;
    const bf16_t* spf = su + ((size_t)(0 * NCH + ch) * 4 + h) * 16384; const bf16_t* spb = su + ((size_t)(1 * NCH + ch) * 4 + h) * 16384;
    u32x4 kreg[4], vreg[4], sfr[4], sbr[4];
#pragma unroll
    for (int it = 0; it < 4; ++it) { const int item = it * NTHR + tid;
        kreg[it] = *(const u32x4*)(qkv + (size_t)(r0 + (item >> 4)) * QKVW + 512 + h * 128 + (item & 15) * 8);
        vreg[it] = *(const u32x4*)(qkv + (size_t)(r0 + (item & 127)) * QKVW + 1024 + h * 128 + (item >> 7) * 8);
        sfr[it] = *(const u32x4*)(spf + (size_t)item * 8); sbr[it] = *(const u32x4*)(spb + (size_t)item * 8); }
    const int w = tid >> 6, lane = tid & 63, fr = lane & 15, fq = lane >> 4, cc = 16 * w + fr;
    bf16x8 qf[4];
#pragma unroll
    for (int kk = 0; kk < 4; ++kk) qf[kk] = gfrag(qkv + (size_t)(r0 + cc) * QKVW + h * 128 + kk * 32 + fq * 8);
#pragma unroll
    for (int it = 0; it < 4; ++it) { const int item = it * NTHR + tid;
        *(LAS u32x4*)(Ks + (item >> 4) * LP + (item & 15) * 8) = kreg[it];
        const int c = item & 127, e0 = (item >> 7) * 8;
#pragma unroll
        for (int e = 0; e < 4; ++e) { VT[(e0 + 2 * e) * LP + c] = (bf16_t)(vreg[it][e] & 0xffffu); VT[(e0 + 2 * e + 1) * LP + c] = (bf16_t)(vreg[it][e] >> 16); } }
    __syncthreads();
#pragma unroll
    for (int st = 0; st < 8; ++st) { f32x4 a = {0.f, 0.f, 0.f, 0.f};
#pragma unroll
        for (int kk = 0; kk < 4; ++kk) a = mfma16(lfrag(Ks, st * 16 + fr, LP, kk * 32 + fq * 8), qf[kk], a);
        float p[4];
#pragma unroll
        for (int r = 0; r < 4; ++r) { const int diff = cc - (st * 16 + 4 * fq + r);
            const float m = diff >= 0 ? __builtin_amdgcn_exp2f(lgf2 * (float)diff) : __builtin_amdgcn_exp2f(-lgb2 * (float)diff); p[r] = a[r] * m; }
        u32x2 o; o.x = pk2(p[0], p[1]); o.y = pk2(p[2], p[3]);
        *(LAS u32x2*)(Ps + cc * LP + st * 16 + 4 * fq) = o; }
    __syncthreads();
#pragma unroll
    for (int it = 0; it < 4; ++it) { const int item = it * NTHR + tid; *(LAS u32x4*)(Ks + (item >> 4) * LP + (item & 15) * 8) = sfr[it]; }
    bf16x8 pf[4];
#pragma unroll
    for (int kk = 0; kk < 4; ++kk) pf[kk] = lfrag(Ps, cc, LP, kk * 32 + fq * 8);
    f32x4 o[8];
#pragma unroll
    for (int et = 0; et < 8; ++et) { o[et] = (f32x4){0.f, 0.f, 0.f, 0.f};
#pragma unroll
        for (int kk = 0; kk < 4; ++kk) o[et] = mfma16(lfrag(VT, et * 16 + fr, LP, kk * 32 + fq * 8), pf[kk], o[et]); }
    __syncthreads();
#pragma unroll
    for (int it = 0; it < 4; ++it) { const int item = it * NTHR + tid; *(LAS u32x4*)(VT + (item >> 4) * LP + (item & 15) * 8) = sbr[it]; }
    { const float qd = __expf(lgf * (float)(cc + 1));
#pragma unroll
      for (int et = 0; et < 8; ++et) { f32x4 a = {0.f, 0.f, 0.f, 0.f};
#pragma unroll
          for (int kk = 0; kk < 4; ++kk) a = mfma16(lfrag(Ks, et * 16 + fr, LP, kk * 32 + fq * 8), qf[kk], a);
          o[et] += a * qd; } }
    __syncthreads();
    { const float qd = __expf(lgb * (float)(128 - cc));
#pragma unroll
      for (int et = 0; et < 8; ++et) { f32x4 a = {0.f, 0.f, 0.f, 0.f};
#pragma unroll
          for (int kk = 0; kk < 4; ++kk) a = mfma16(lfrag(VT, et * 16 + fr, LP, kk * 32 + fq * 8), qf[kk], a);
          o[et] += a * qd; } }
    float ss = 0.f;
#pragma unroll
    for (int et = 0; et < 8; ++et) ss += (o[et][0] * o[et][0] + o[et][1] * o[et][1]) + (o[et][2] * o[et][2] + o[et][3] * o[et][3]);
    ss += __shfl_xor(ss, 16); ss += __shfl_xor(ss, 32);
    const float rstd = 1.0f / sqrtf(ss * (1.f / 128.f) + EPS);
#pragma unroll
    for (int et = 0; et < 8; ++et) { bf16_t* gp = zb + (size_t)(r0 + cc) * ZBW + h * 128 + et * 16 + 4 * fq;
        const u32x2 gv = *(const u32x2*)gp; u32x2 ov;
        ov.x = pk2(o[et][0] * rstd * bflo(gv.x), o[et][1] * rstd * bfhi(gv.x)); ov.y = pk2(o[et][2] * rstd * bflo(gv.y), o[et][3] * rstd * bfhi(gv.y));
        *(u32x2*)gp = ov; }
    __syncthreads();
}

__device__ __forceinline__ void unit_fa(LAS unsigned char* L, const bf16_t* zb, bf16_t* T, int uidx, int tid) {
    asm volatile("" : "+v"(tid));
    const int b = uidx >> 7, g = (uidx >> 5) & 3, l2b = (uidx & 31) * 4;
    const LAS bf16_t* TC = (const LAS bf16_t*)(L + TBL_OFF); const LAS bf16_t* TS = TC + 64 * LP64; const LAS bf16_t* TN = TS + 64 * LP64;
    const int w = tid >> 6, lane = tid & 63, fr = lane & 15, fq = lane >> 4;
    { const int it = w >> 1, jt0 = 2 * (w & 1);
      bf16x8 xf[4][2];
#pragma unroll
      for (int jb = 0; jb < 4; ++jb) { const bf16_t* xp = zb + (size_t)(b * SEQ + 128 * (it * 16 + fr) + l2b + jb) * ZBW + 512 + g * 64 + fq * 8; xf[jb][0] = gfrag(xp); xf[jb][1] = gfrag(xp + 32); }
#pragma unroll
      for (int jb = 0; jb < 4; ++jb) { LAS bf16_t* ZrT = (LAS bf16_t*)L + jb * 2 * 64 * LP64; LAS bf16_t* ZiT = ZrT + 64 * LP64;
#pragma unroll
        for (int jj = 0; jj < 2; ++jj) { const int jt = jt0 + jj; f32x4 zr = {0.f, 0.f, 0.f, 0.f}, zi = {0.f, 0.f, 0.f, 0.f};
#pragma unroll
          for (int kk = 0; kk < 2; ++kk) { zr = mfma16(xf[jb][kk], lfrag(TC, jt * 16 + fr, LP64, kk * 32 + fq * 8), zr); zi = mfma16(xf[jb][kk], lfrag(TN, jt * 16 + fr, LP64, kk * 32 + fq * 8), zi); }
          u32x2 o; o.x = pk2(zr[0], zr[1]); o.y = pk2(zr[2], zr[3]); *(LAS u32x2*)(ZrT + (jt * 16 + fr) * LP64 + it * 16 + 4 * fq) = o;
          o.x = pk2(zi[0], zi[1]); o.y = pk2(zi[2], zi[3]); *(LAS u32x2*)(ZiT + (jt * 16 + fr) * LP64 + it * 16 + 4 * fq) = o; } } }
    __syncthreads();
    { const int ct = w >> 1, kt0 = 2 * (w & 1);
#pragma unroll
      for (int jb = 0; jb < 4; ++jb) { const LAS bf16_t* ZrT = (const LAS bf16_t*)L + jb * 2 * 64 * LP64; const LAS bf16_t* ZiT = ZrT + 64 * LP64; const int l2 = l2b + jb;
        bf16x8 xr[2], xi[2];
#pragma unroll
        for (int kk = 0; kk < 2; ++kk) { xr[kk] = lfrag(ZrT, ct * 16 + fr, LP64, kk * 32 + fq * 8); xi[kk] = lfrag(ZiT, ct * 16 + fr, LP64, kk * 32 + fq * 8); }
#pragma unroll
        for (int jj = 0; jj < 2; ++jj) { const int kt = kt0 + jj; f32x4 ar = {0.f, 0.f, 0.f, 0.f}, ai = {0.f, 0.f, 0.f, 0.f};
#pragma unroll
          for (int kk = 0; kk < 2; ++kk) { const bf16x8 yc = lfrag(TC, kt * 16 + fr, LP64, kk * 32 + fq * 8), ys = lfrag(TS, kt * 16 + fr, LP64, kk * 32 + fq * 8), yn = lfrag(TN, kt * 16 + fr, LP64, kk * 32 + fq * 8);
              ar = mfma16(xr[kk], yc, ar); ar = mfma16(xi[kk], ys, ar); ai = mfma16(xi[kk], yc, ai); ai = mfma16(xr[kk], yn, ai); }
          const int k1 = kt * 16 + fr; const float fv = (float)((l2 * k1) & 8191) * (1.f / 8192.f); const float tc = cos_rev(fv), ts = sin_rev(fv);
          bf16_t* tp = T + ((size_t)((b * 4 + g) * 128 + l2) * 64 + k1) * 128 + ct * 16 + 4 * fq;
          u32x2 o; o.x = pk2(ar[0] * tc + ai[0] * ts, ar[1] * tc + ai[1] * ts); o.y = pk2(ar[2] * tc + ai[2] * ts, ar[3] * tc + ai[3] * ts); *(u32x2*)tp = o;
          o.x = pk2(ai[0] * tc - ar[0] * ts, ai[1] * tc - ar[1] * ts); o.y = pk2(ai[2] * tc - ar[2] * ts, ai[3] * tc - ar[3] * ts); *(u32x2*)(tp + 64) = o; } } }
    __syncthreads();
}

__device__ __forceinline__ void unit_fb(LAS unsigned char* L, bf16_t* zb, const bf16_t* T, int uidx, int tid) {
    asm volatile("" : "+v"(tid));
    const int b = uidx >> 8, g = (uidx >> 6) & 3, k1 = uidx & 63;
    const LAS bf16_t* Wc = (const LAS bf16_t*)L; const LAS bf16_t* Ws = Wc + 128 * LP;
    LAS bf16_t* ArT = (LAS bf16_t*)L + 2 * 128 * LP; LAS bf16_t* AiT = ArT + 64 * LP;
#pragma unroll
    for (int it = 0; it < 4; ++it) { const int item = it * NTHR + tid, l2 = item >> 4, ck = item & 15;
        const u32x4 vv = *(const u32x4*)(T + ((size_t)((b * 4 + g) * 128 + l2) * 64 + k1) * 128 + ck * 8);
        LAS bf16_t* dst = (ck < 8) ? ArT : AiT; const int c0 = (ck & 7) * 8;
#pragma unroll
        for (int e = 0; e < 4; ++e) { dst[(c0 + 2 * e) * LP + l2] = (bf16_t)(vv[e] & 0xffffu); dst[(c0 + 2 * e + 1) * LP + l2] = (bf16_t)(vv[e] >> 16); } }
    __syncthreads();
    const int w = tid >> 6, lane = tid & 63, fr = lane & 15, fq = lane >> 4;
    bf16x8 yc[4], ys[4];
#pragma unroll
    for (int kk = 0; kk < 4; ++kk) { yc[kk] = lfrag(Wc, 16 * w + fr, LP, kk * 32 + fq * 8); ys[kk] = lfrag(Ws, 16 * w + fr, LP, kk * 32 + fq * 8); }
    const size_t row = (size_t)(b * SEQ + k1 + 64 * (16 * w + fr));
#pragma unroll
    for (int it = 0; it < 4; ++it) { f32x4 a = {0.f, 0.f, 0.f, 0.f};
#pragma unroll
        for (int kk = 0; kk < 4; ++kk) { a = mfma16(lfrag(ArT, it * 16 + fr, LP, kk * 32 + fq * 8), yc[kk], a); a = mfma16(lfrag(AiT, it * 16 + fr, LP, kk * 32 + fq * 8), ys[kk], a); }
        const float sc = 0.0013810679320049757f;
        u32x2 o; o.x = pk2(a[0] * sc, a[1] * sc); o.y = pk2(a[2] * sc, a[3] * sc);
        *(u32x2*)(zb + row * ZBW + 512 + g * 64 + it * 16 + 4 * fq) = o; }
    __syncthreads();
}

__device__ __forceinline__ void unit_fc(LAS unsigned char* L, bf16_t* zb, int uidx, int tid) {
    asm volatile("" : "+v"(tid));
    const int b = uidx >> 2, g = uidx & 3, rb = ML + b * CTXL;
    const LAS bf16_t* TC = (const LAS bf16_t*)(L + TBL_OFF); const LAS bf16_t* TN = TC + 2 * 64 * LP64;
    LAS bf16_t* ZrT = (LAS bf16_t*)L; LAS bf16_t* ZiT = ZrT + 64 * LPC;
    const int w = tid >> 6, lane = tid & 63, fr = lane & 15, fq = lane >> 4;
#pragma unroll
    for (int ii = 0; ii < 2; ++ii) { const int it = 2 * w + ii;
        const bf16_t* xp = zb + (size_t)(rb + it * 16 + fr) * ZBW + 512 + g * 64 + fq * 8;
        bf16x8 xf[2]; xf[0] = gfrag(xp); xf[1] = gfrag(xp + 32);
#pragma unroll
        for (int jt = 0; jt < 4; ++jt) { f32x4 zr = {0.f, 0.f, 0.f, 0.f}, zi = {0.f, 0.f, 0.f, 0.f};
#pragma unroll
            for (int kk = 0; kk < 2; ++kk) { zr = mfma16(xf[kk], lfrag(TC, jt * 16 + fr, LP64, kk * 32 + fq * 8), zr); zi = mfma16(xf[kk], lfrag(TN, jt * 16 + fr, LP64, kk * 32 + fq * 8), zi); }
            u32x2 o; o.x = pk2(zr[0], zr[1]); o.y = pk2(zr[2], zr[3]); *(LAS u32x2*)(ZrT + (jt * 16 + fr) * LPC + it * 16 + 4 * fq) = o;
            o.x = pk2(zi[0], zi[1]); o.y = pk2(zi[2], zi[3]); *(LAS u32x2*)(ZiT + (jt * 16 + fr) * LPC + it * 16 + 4 * fq) = o; } }
    __syncthreads();
#pragma unroll 1
    for (int ii = 0; ii < 2; ++ii) { const int lp = (2 * w + ii) * 16 + fr;
        f32x4 a[4];
#pragma unroll
        for (int i2 = 0; i2 < 4; ++i2) a[i2] = (f32x4){0.f, 0.f, 0.f, 0.f};
#pragma unroll 1
        for (int kk = 0; kk < 8; ++kk) { u32x4 cw, sw;
#pragma unroll
            for (int e = 0; e < 4; ++e) { const int l0 = kk * 32 + fq * 8 + 2 * e; const float f0 = (float)((l0 * lp) & 255) * (1.f / 256.f), f1 = (float)(((l0 + 1) * lp) & 255) * (1.f / 256.f);
                cw[e] = pk2(cos_rev(f0), cos_rev(f1)); sw[e] = pk2(sin_rev(f0), sin_rev(f1)); }
            const bf16x8 yc = __builtin_bit_cast(bf16x8, cw), ys = __builtin_bit_cast(bf16x8, sw);
#pragma unroll
            for (int i2 = 0; i2 < 4; ++i2) { a[i2] = mfma16(lfrag(ZrT, i2 * 16 + fr, LPC, kk * 32 + fq * 8), yc, a[i2]); a[i2] = mfma16(lfrag(ZiT, i2 * 16 + fr, LPC, kk * 32 + fq * 8), ys, a[i2]); } }
#pragma unroll
        for (int i2 = 0; i2 < 4; ++i2) { u32x2 o; o.x = pk2(a[i2][0] * 0.0078125f, a[i2][1] * 0.0078125f); o.y = pk2(a[i2][2] * 0.0078125f, a[i2][3] * 0.0078125f);
            *(u32x2*)(zb + (size_t)(rb + lp) * ZBW + 512 + g * 64 + i2 * 16 + 4 * fq) = o; } }
    __syncthreads();
}

__device__ __forceinline__ void unit_sgu(LAS unsigned char* L, bf16_t* zb, const float* ws, const float* bs, const float* gn, int ch, int g, int tid) {
    asm volatile("" : "+v"(tid));
    const int r0 = chunk_row0(ch);
    LAS bf16_t* VT = (LAS bf16_t*)L;
#pragma unroll
    for (int it = 0; it < 2; ++it) { const int item = it * NTHR + tid, row = item >> 3, ck = item & 7;
        const u32x4 vv = *(const u32x4*)(zb + (size_t)(r0 + row) * ZBW + 1024 + g * 64 + ck * 8);
        float f[8]; float ss = 0.f;
#pragma unroll
        for (int e = 0; e < 4; ++e) { f[2 * e] = bflo(vv[e]); f[2 * e + 1] = bfhi(vv[e]); ss += f[2 * e] * f[2 * e] + f[2 * e + 1] * f[2 * e + 1]; }
        ss += __shfl_xor(ss, 1); ss += __shfl_xor(ss, 2); ss += __shfl_xor(ss, 4);
        const float rstd = 1.0f / sqrtf(ss * (1.f / 64.f) + EPS);
#pragma unroll
        for (int i = 0; i < 8; ++i) VT[(ck * 8 + i) * LP + row] = f2bf(f[i] * rstd * gn[g * 64 + ck * 8 + i]); }
    __syncthreads();
    const int w = tid >> 6, lane = tid & 63, fr = lane & 15, fq = lane >> 4, t = 16 * w + fr;
    bf16x8 yw[4];
#pragma unroll
    for (int kk = 0; kk < 4; ++kk) { const float* wp = ws + (size_t)(g * 128 + t) * 128 + kk * 32 + fq * 8; const f32x4 a = *(const f32x4*)wp, b = *(const f32x4*)(wp + 4);
        u32x4 pw; pw.x = pk2(a.x, a.y); pw.y = pk2(a.z, a.w); pw.z = pk2(b.x, b.y); pw.w = pk2(b.z, b.w); yw[kk] = __builtin_bit_cast(bf16x8, pw); }
    const float bias = bs[g * 128 + t];
#pragma unroll
    for (int it = 0; it < 4; ++it) { f32x4 a = {0.f, 0.f, 0.f, 0.f};
#pragma unroll
        for (int kk = 0; kk < 4; ++kk) a = mfma16(lfrag(VT, it * 16 + fr, LP, kk * 32 + fq * 8), yw[kk], a);
        bf16_t* up = zb + (size_t)(r0 + t) * ZBW + 768 + g * 64 + it * 16 + 4 * fq;
        const u32x2 uv = *(const u32x2*)up; u32x2 o;
        o.x = pk2(bflo(uv.x) * (a[0] + bias), bfhi(uv.x) * (a[1] + bias)); o.y = pk2(bflo(uv.y) * (a[2] + bias), bfhi(uv.y) * (a[3] + bias));
        *(u32x2*)up = o; }
    __syncthreads();
}


#ifdef DBG_NANSCAN
__device__ __forceinline__ bool dbg_scan_rg(const unsigned char* base, size_t bytes, bool f32, int gtid, int gn) {
    const unsigned* p = (const unsigned*)base; const size_t n = bytes / 4; bool bad = false;
    for (size_t i = gtid; i < n; i += gn) { const unsigned v = p[i]; if (f32) { if ((v & 0x7F800000u) == 0x7F800000u) bad = true; } else if ((v & 0x7F80u) == 0x7F80u || (v & 0x7F800000u) == 0x7F800000u) bad = true; }
    return bad;
}
__device__ __forceinline__ bool dbg_huge_rg(const unsigned char* base, size_t bytes, bool f32, int gtid, int gn) {
    const unsigned* p = (const unsigned*)base; const size_t n = bytes / 4; bool bad = false;
    for (size_t i = gtid; i < n; i += gn) { const unsigned v = p[i]; if ((v & 0x7F800000u) >= 0x44800000u) bad = true; if (!f32 && (v & 0x7F80u) >= 0x4480u) bad = true; }
    return bad;
}
__device__ __forceinline__ void dbg_scan(unsigned char* ws, int code, int k0only, int gtid, int gn) {
    unsigned* flag = (unsigned*)ws; bool bad = false;
    { unsigned m = 0;
      if (code == 0) { if (dbg_huge_rg(ws + WS_MOD, 147456, true, gtid, gn)) m |= 1u; if (dbg_huge_rg(ws + WS_W, WS_HN - WS_W, false, gtid, gn)) m |= 2u; }
      if (code == 1) { if (dbg_huge_rg(ws + WS_HN, (size_t)MT * D * 2, false, gtid, gn)) m |= 4u; }
      if (code == 2) { if (dbg_huge_rg(ws + WS_BIG, BIG_SU, false, gtid, gn)) m |= 8u; if (dbg_huge_rg(ws + WS_ZB, (size_t)MT * ZBW * 2, false, gtid, gn)) m |= 16u; }
      if (m) atomicOr(flag + 1, m); }
    const int ph = code < 2 ? code : 2 + (code - 2) % 11;
    const size_t HNB = (size_t)MT * D * 2, ZBB = (size_t)MT * ZBW * 2, BIGB = (size_t)MT * NGW * 2;
    if (ph == 0) { bad |= dbg_scan_rg(ws + WS_MOD, 147456, true, gtid, gn); bad |= dbg_scan_rg(ws + WS_W, WS_HN - WS_W, false, gtid, gn); }
    else if (ph == 1 || ph == 7 || ph == 9 || ph == 11 || ph == 12) bad |= dbg_scan_rg(ws + WS_HN, HNB, false, gtid, gn);
    else if (ph == 2) { bad |= dbg_scan_rg(ws + WS_ZB, ZBB, false, gtid, gn); bad |= dbg_scan_rg(ws + WS_BIG, BIG_SU, false, gtid, gn); }
    else if (ph == 3) { unsigned m = 0;
        if (dbg_scan_rg(ws + WS_ZB, (size_t)ML * ZBW * 2, false, gtid, gn)) m |= 1u;
        if (dbg_scan_rg(ws + WS_ZB + (size_t)ML * ZBW * 2, (size_t)MC * ZBW * 2, false, gtid, gn)) m |= 2u;
        if (dbg_scan_rg(ws + WS_BIG, BIG_SU, false, gtid, gn)) m |= 4u;
        if (dbg_scan_rg(ws + WS_BIG + BIG_SU, BIG_T - BIG_SU, false, gtid, gn)) m |= 8u;
        if (dbg_scan_rg(ws + WS_BIG + BIG_T, 16777216, false, gtid, gn)) m |= 16u;
        bad = m != 0; }
    else if (ph == 4) { bad |= dbg_scan_rg(ws + WS_ZB, ZBB, false, gtid, gn); bad |= dbg_scan_rg(ws + WS_BIG + BIG_SU, BIG_T - BIG_SU, false, gtid, gn); }
    else if (ph == 5) bad |= dbg_scan_rg(ws + WS_ZB, ZBB, false, gtid, gn);
    else if (ph == 6) bad |= dbg_scan_rg(ws + WS_BIG, BIGB, false, gtid, gn);
    else if (ph == 8) bad |= dbg_scan_rg(ws + WS_BIG, HNB, false, gtid, gn);
    else if (ph == 10) bad |= dbg_scan_rg(ws + WS_ZB, (size_t)MT * FF * 2, false, gtid, gn);
    if (bad) atomicMin(flag, (unsigned)code);
}
#endif
#ifdef PROBE_B
#define PROBE_G2(x) x
#else
#define PROBE_G2(x)
#endif
struct Args { const float* in[21]; float* out; unsigned char* ws; int ph_lo, ph_hi; };
constexpr int NPHASE = 24;

__global__ void __launch_bounds__(NTHR, 2) fwd_kernel(Args args) {
    extern __shared__ __attribute__((aligned(16))) unsigned char lds_raw[];
    LAS unsigned char* L = (LAS unsigned char*)lds_raw;
    cg::grid_group grid = cg::this_grid();
    const int wave = __builtin_amdgcn_readfirstlane((int)threadIdx.x >> 6);
#define FRESH_TID int tid = (int)threadIdx.x; asm volatile("" : "+v"(tid)); const int lane = tid & 63; (void)lane;
    const int G = gridDim.x, bx = blockIdx.x;
    const int gw = bx * NWAVES + wave, NGWV = G * NWAVES;
    unsigned char* ws = args.ws;
    float* MOD = (float*)(ws + WS_MOD); float* CTXS = (float*)(ws + WS_CTXS);
    bf16_t* WB = (bf16_t*)(ws + WS_W); bf16_t* HN = (bf16_t*)(ws + WS_HN); bf16_t* ZB = (bf16_t*)(ws + WS_ZB);
    bf16_t* QKV = (bf16_t*)(ws + WS_BIG + BIG_QKV); bf16_t* SU = (bf16_t*)(ws + WS_BIG + BIG_SU); bf16_t* TT = (bf16_t*)(ws + WS_BIG + BIG_T);
    bf16_t* GATES = (bf16_t*)(ws + WS_BIG); bf16_t* YB = (bf16_t*)(ws + WS_BIG); bf16_t* HID = (bf16_t*)(ws + WS_ZB);
    const float* x_in = args.in[0]; const float* ctx_in = args.in[2]; float* xout = args.out;
    const int lo = args.ph_lo, hi = args.ph_hi;
    volatile LAS unsigned* xst = (volatile LAS unsigned*)(L + LDS_BYTES - 64);
    if (threadIdx.x < 2) xst[threadIdx.x] = 0u;
    __syncthreads();
    XcdBarrier xbar = xcd_barrier_post((unsigned*)(ws + 4096), xst);
    if (hi - lo > 1) grid.sync();
#ifdef DBG_NANSCAN
    if (bx == 0 && threadIdx.x == 0) { __hip_atomic_store((unsigned*)ws, 0xFFFFFFFFu, __ATOMIC_RELAXED, __HIP_MEMORY_SCOPE_AGENT); __hip_atomic_store((unsigned*)ws + 1, 0u, __ATOMIC_RELAXED, __HIP_MEMORY_SCOPE_AGENT); }
#endif
#define PH(k) (lo <= (k) && (k) < hi)
#ifdef DBG_NANSCAN
#define DBGSCAN(k) do { int t_ = (int)threadIdx.x; asm volatile("" : "+v"(t_)); dbg_scan(ws, (k), (k) == 0, bx * NTHR + t_, G * NTHR); } while (0)
#else
#define DBGSCAN(k)
#endif
#define CG_SYNC() do { __builtin_amdgcn_fence(__ATOMIC_RELEASE, "agent"); asm volatile("s_waitcnt vmcnt(0) lgkmcnt(0)" ::: "memory"); grid.sync(); __builtin_amdgcn_fence(__ATOMIC_ACQUIRE, "agent"); asm volatile("s_waitcnt vmcnt(0)" ::: "memory"); } while (0)
#ifdef PROBE_A
#define PROBE_SYNC2(k) xcd_barrier(xbar);
#else
#define PROBE_SYNC2(k)
#endif
#define SEAM(k) do { if (PH(k) && PH((k) + 1)) { xcd_barrier(xbar); PROBE_SYNC2(k) DBGSCAN(k); } } while (0)

    if (PH(0)) {
        FRESH_TID
        if (bx < 192) {
            LAS float* scv = (LAS float*)L;
            LAS float* red = scv + 3 * 1024;
            for (int i = tid; i < 3 * 1024; i += NTHR) { const float c = (i < 2048) ? args.in[1][i] : args.in[3][i - 2048]; scv[i] = c / (1.f + __expf(-c)); }
            __syncthreads();
            for (int it = bx; it < 192; it += G) { const int l = it / 96, n0 = (it % 96) * 64;
                const float* wp = args.in[4] + ((size_t)l * D + wave * 128) * 6144 + n0 + lane;
                float a0 = 0.f, a1 = 0.f, a2 = 0.f;
#pragma unroll 8
                for (int k = 0; k < 128; ++k) { const float wv = wp[(size_t)k * 6144]; const int kk = wave * 128 + k; a0 += scv[kk] * wv; a1 += scv[1024 + kk] * wv; a2 += scv[2048 + kk] * wv; }
                red[(wave * 3 + 0) * 64 + lane] = a0; red[(wave * 3 + 1) * 64 + lane] = a1; red[(wave * 3 + 2) * 64 + lane] = a2;
                __syncthreads();
                if (tid < 192) { const int slot = tid >> 6, n = tid & 63; float s = args.in[5][l * 6144 + n0 + n];
#pragma unroll
                    for (int w8 = 0; w8 < 8; ++w8) s += red[(w8 * 3 + slot) * 64 + n];
                    MOD[(size_t)(l * 3 + slot) * 6144 + n0 + n] = s; }
                __syncthreads(); }
        }
        __syncthreads();
        LAS float* scr = (LAS float*)(L + wave * 8448);
        constexpr int C0 = 2944, C1 = C0 + 256, C2 = C1 + 128, C3 = C2 + 128, C4 = C3 + 512, C5 = C4 + 2048, C6 = C5 + 2048;
        for (int it = gw; it < 2 * C6; it += NGWV) { const int l = it / C6; int r = it % C6; bf16_t* wl = WB + (size_t)l * WL_EL;
            if (r < C0) tr_item(args.in[10] + (size_t)l * D * INW, INW, wl + WL_IN, D, 0, scr, r, lane);
            else if (r < C1) tr_item(args.in[15] + (size_t)l * 512 * D, D, wl + WL_CAT, D, 0, scr, r - C0, lane);
            else if (r < C2) tr_item(args.in[16] + (size_t)l * 256 * D, D, wl + WL_CAT, D, 512, scr, r - C1, lane);
            else if (r < C3) tr_item(args.in[17] + (size_t)l * 256 * D, D, wl + WL_CAT, D, 768, scr, r - C2, lane);
            else if (r < C4) tr_item(args.in[18] + (size_t)l * D * D, D, wl + WL_O, D, 0, scr, r - C3, lane);
            else if (r < C5) tr_item(args.in[19] + (size_t)l * D * FF, FF, wl + WL_UP, D, 0, scr, r - C4, lane);
            else tr_item(args.in[20] + (size_t)l * FF * D, D, wl + WL_DN, FF, 0, scr, r - C5, lane); }
    }
    SEAM(0);
    if (PH(1)) {
        FRESH_TID
        for (int r = gw; r < MT; r += NGWV) { const float* xr = r < ML ? x_in + (size_t)r * D : ctx_in + (size_t)(r - ML) * D;
            const int slot = r < SEQ ? 0 : (r < ML ? 1 : 2); const float* md = MOD + (size_t)slot * 6144;
            f32x4 v[4];
#pragma unroll
            for (int j = 0; j < 4; ++j) v[j] = *(const f32x4*)(xr + 4 * lane + 256 * j);
            modnorm_store(v, args.in[6], md + 1024, md, HN + (size_t)r * D, lane); }
    }
    SEAM(1);

#pragma unroll 1
    for (int l = 0; l < 2; ++l) {
        const int P = 2 + 11 * l; const bool last = (l == 1);
        const bf16_t* wl = WB + (size_t)l * WL_EL;
        const float* dlog = args.in[11] + l * 8;
        const int Mrows = last ? ML : MT;
        if (PH(P + 0)) { pg8::Gemm g{HN, wl + WL_IN, MT, N1W, D, D}; pg8::StaticOrder S; S.init(MT, N1W, G, bx);
            pg8::EpiZ1 E{QKV, ZB}; pg8::gemm_phase<pg8::EpiZ1>(L, g, S, E); PROBE_G2(pg8::gemm_phase<pg8::EpiZ1>(L, g, S, E)); }
        SEAM(P + 0);
        if (PH(P + 1)) {
            FRESH_TID
            { LAS bf16_t* TC = (LAS bf16_t*)(L + TBL_OFF);
              for (int i = tid; i < 4096; i += NTHR) { const int k = i >> 6, n = i & 63; const float fv = (float)((k * n) & 63) * (1.f / 64.f); const float c = cos_rev(fv), s = sin_rev(fv);
                  TC[k * LP64 + n] = f2bf(c); TC[64 * LP64 + k * LP64 + n] = f2bf(s); TC[2 * 64 * LP64 + k * LP64 + n] = f2bf(-s); } }
            __syncthreads();
            const int nRB = NCH * 4, nSG = (last ? 128 : NCH) * 4, nFA = 256, nFC = last ? 0 : 8;
            for (int it = bx; it < nRB + nSG + nFA + nFC; it += G) {
                if (it < nRB) unit_rb(L, QKV, SU, dlog, it >> 2, it & 3, tid);
                else if (it < nRB + nSG) { const int u = it - nRB; unit_sgu(L, ZB, args.in[12] + (size_t)l * 4 * 128 * 128, args.in[13] + l * 512, args.in[14] + l * 256, u >> 2, u & 3, tid); }
                else if (it < nRB + nSG + nFA) unit_fa(L, ZB, TT, it - nRB - nSG, tid);
                else unit_fc(L, ZB, it - nRB - nSG - nFA, tid);
            }
        }
        SEAM(P + 1);
        if (PH(P + 2)) {
            FRESH_TID
            { LAS bf16_t* Wc = (LAS bf16_t*)L;
              for (int i = tid; i < 16384; i += NTHR) { const int k = i >> 7, n = i & 127; const float fv = (float)((k * n) & 127) * (1.f / 128.f);
                  Wc[k * LP + n] = f2bf(cos_rev(fv)); Wc[128 * LP + k * LP + n] = f2bf(sin_rev(fv)); } }
            __syncthreads();
            for (int it = bx; it < 256 + 512; it += G) {
                if (it < 256) scan_item((unsigned*)SU, dlog, it, tid);
                else unit_fb(L, ZB, TT, it - 256, tid);
            }
        }
        SEAM(P + 2);
        if (PH(P + 3)) { FRESH_TID const int nRD = (last ? 128 : NCH) * 4;
            for (int it = bx; it < nRD; it += G) unit_rd(L, QKV, ZB, SU, dlog, it >> 2, it & 3, tid); }
        SEAM(P + 3);
        if (PH(P + 4)) { pg8::Gemm g{HN, wl + WL_IN + (size_t)N1W * D, Mrows, NGW, D, D}; pg8::StaticOrder S; S.init(Mrows, NGW, G, bx);
            pg8::EpiAct E{GATES, NGW, 3}; pg8::gemm_phase<pg8::EpiAct>(L, g, S, E); PROBE_G2(pg8::gemm_phase<pg8::EpiAct>(L, g, S, E)); }
        SEAM(P + 4);
        if (PH(P + 5)) { pg8::Gemm g{ZB, wl + WL_CAT, Mrows, D, D, ZBW}; pg8::StaticOrder S; S.init(Mrows, D, G, bx);
            pg8::EpiGate E{GATES, HN}; pg8::gemm_phase<pg8::EpiGate>(L, g, S, E); PROBE_G2(pg8::gemm_phase<pg8::EpiGate>(L, g, S, E)); }
        SEAM(P + 5);
        if (PH(P + 6)) { pg8::Gemm g{HN, wl + WL_O, Mrows, D, D, D}; pg8::StaticOrder S; S.init(Mrows, D, G, bx);
            pg8::EpiAct E{YB, D, 0}; pg8::gemm_phase<pg8::EpiAct>(L, g, S, E); PROBE_G2(pg8::gemm_phase<pg8::EpiAct>(L, g, S, E)); }
        SEAM(P + 6);
        if (PH(P + 7)) {
            FRESH_TID
            for (int r = gw; r < Mrows; r += NGWV) { const bool lat = r < ML;
                const float* xs = lat ? (l == 0 ? x_in + (size_t)r * D : xout + (size_t)r * D) : (l == 0 ? ctx_in + (size_t)(r - ML) * D : CTXS + (size_t)(r - ML) * D);
                float* xd = lat ? xout + (size_t)r * D : CTXS + (size_t)(r - ML) * D;
                const int slot = r < SEQ ? 0 : (r < ML ? 1 : 2); const float* md = MOD + (size_t)(l * 3 + slot) * 6144;
                row_update(YB + (size_t)r * D, xs, xd, args.in[7] + l * D, md + 2048, args.in[8] + l * D, md + 4096, md + 3072, HN + (size_t)r * D, lane); }
        }
        SEAM(P + 7);
        if (PH(P + 8)) { pg8::Gemm g{HN, wl + WL_UP, Mrows, FF, D, D}; pg8::StaticOrder S; S.init(Mrows, FF, G, bx);
            pg8::EpiAct E{HID, FF, 4}; pg8::gemm_phase<pg8::EpiAct>(L, g, S, E); PROBE_G2(pg8::gemm_phase<pg8::EpiAct>(L, g, S, E)); }
        SEAM(P + 8);
        if (PH(P + 9)) { pg8::Gemm g{HID, wl + WL_DN, Mrows, D, FF, FF}; pg8::StaticOrder S; S.init(Mrows, D, G, bx);
            pg8::EpiAct E{HN, D, 0}; pg8::gemm_phase<pg8::EpiAct>(L, g, S, E); PROBE_G2(pg8::gemm_phase<pg8::EpiAct>(L, g, S, E)); }
        SEAM(P + 9);
        if (PH(P + 10)) {
            FRESH_TID
            for (int r = gw; r < Mrows; r += NGWV) { const bool lat = r < ML;
                float* xd = lat ? xout + (size_t)r * D : CTXS + (size_t)(r - ML) * D;
                const int slot = r < SEQ ? 0 : (r < ML ? 1 : 2); const float* md = MOD + (size_t)(l * 3 + slot) * 6144;
                const float* mdn = MOD + (size_t)(3 + slot) * 6144;
                row_update(HN + (size_t)r * D, xd, xd, args.in[9] + l * D, md + 5120, args.in[6] + D, mdn + 1024, mdn, last ? nullptr : HN + (size_t)r * D, lane); }
        }
        if (!last) SEAM(P + 10);
    }
#ifdef DBG_NANSCAN
    DBGSCAN(23);
    __builtin_amdgcn_fence(__ATOMIC_RELEASE, "agent"); asm volatile("s_waitcnt vmcnt(0) lgkmcnt(0)" ::: "memory"); grid.sync(); __builtin_amdgcn_fence(__ATOMIC_ACQUIRE, "agent");
    { const unsigned fl = __hip_atomic_load((unsigned*)ws, __ATOMIC_RELAXED, __HIP_MEMORY_SCOPE_AGENT);
      for (size_t i = (size_t)bx * NTHR + threadIdx.x; i < (size_t)ML * D; i += (size_t)G * NTHR) xout[i] = (i == 0) ? 1000.f * (float)(__hip_atomic_load((unsigned*)ws + 1, __ATOMIC_RELAXED, __HIP_MEMORY_SCOPE_AGENT) + 1u) + 0.f * (float)fl : 0.f; }
#endif
#undef PH
#undef SEAM
#undef FRESH_TID
}

#ifndef MK_PER_PHASE
#define MK_PER_PHASE 0
#endif
extern "C" void kernel_launch(void* const* d_in, const int* in_sizes, int n_in, void* d_out, int out_size, void* d_ws, size_t ws_size, hipStream_t stream) {
    static int grid = 0;
    if (grid == 0) {
        if (n_in != 21 || ws_size < WS_END) { fprintf(stderr, "kernel_launch: unexpected n_in %d / ws_size %zu (need %zu)\n", n_in, ws_size, (size_t)WS_END); grid = -1; return; }
        int dev = 0, cus = 0, per_cu = 0;
        hipGetDevice(&dev); hipDeviceGetAttribute(&cus, hipDeviceAttributeMultiprocessorCount, dev);
        if (hipFuncSetAttribute((const void*)fwd_kernel, hipFuncAttributeMaxDynamicSharedMemorySize, LDS_BYTES) != hipSuccess) { fprintf(stderr, "kernel_launch: hipFuncSetAttribute failed\n"); grid = -1; return; }
        if (hipOccupancyMaxActiveBlocksPerMultiprocessor(&per_cu, (const void*)fwd_kernel, NTHR, LDS_BYTES) != hipSuccess || per_cu < 1) { fprintf(stderr, "kernel_launch: occupancy query failed (%d)\n", per_cu); (void)hipGetLastError(); per_cu = 1; }
        if (per_cu > 1) per_cu = 1;
        grid = cus * per_cu;
    }
    if (grid < 0) return;
    if (hipMemsetAsync(d_ws, 0, 65536, stream) != hipSuccess) { fprintf(stderr, "kernel_launch: memset failed\n"); return; }
    Args a{};
    for (int i = 0; i < 21; ++i) a.in[i] = (const float*)d_in[i];
    a.out = (float*)d_out; a.ws = (unsigned char*)d_ws;
#if MK_PER_PHASE
    for (int p = 0; p < NPHASE; ++p) { a.ph_lo = p; a.ph_hi = p + 1; hipLaunchKernelGGL(fwd_kernel, dim3(grid), dim3(NTHR), LDS_BYTES, stream, a); }
#else
    a.ph_lo = 0; a.ph_hi = NPHASE;
    void* kargs[] = {&a};
    hipError_t e = hipLaunchCooperativeKernel((const void*)fwd_kernel, dim3(grid), dim3(NTHR), kargs, LDS_BYTES, stream);
    if (e != hipSuccess) fprintf(stderr, "kernel_launch: cooperative launch failed: %s (grid %d)\n", hipGetErrorString(e), grid);
#endif
}
```

```cpp
#include <hip/hip_runtime.h>
#include <hip/hip_cooperative_groups.h>
#include <cstdio>
#include <cstdint>
namespace cg = cooperative_groups;

#define LAS __attribute__((address_space(3)))
typedef unsigned short bf16_t;
typedef short bf16x8 __attribute__((ext_vector_type(8)));
typedef float f32x4 __attribute__((ext_vector_type(4)));
typedef unsigned u32x4 __attribute__((ext_vector_type(4)));
typedef unsigned u32x2 __attribute__((ext_vector_type(2)));

constexpr int D = 1024, SEQ = 8192, NB = 2, ML = NB * SEQ, CTXL = 256, MC = NB * CTXL, MT = ML + MC;
constexpr int INW = 5888, N1W = 2816, NGW = 3072, FF = 4096;
constexpr int QKVW = 1536, ZBW = 1280;
constexpr int NCH = MT / 128;
constexpr float EPS = 1e-6f;
constexpr int NTHR = 512, NWAVES = 8;
constexpr int LDS_BYTES = 147456;

constexpr size_t WS_MOD = 65536;
constexpr size_t WS_CTXS = 262144;
constexpr size_t WS_W = 2359296;
constexpr size_t WL_IN = 0, WL_CAT = (size_t)INW * D, WL_O = WL_CAT + (size_t)D * D, WL_UP = WL_O + (size_t)D * D, WL_DN = WL_UP + (size_t)FF * D, WL_EL = WL_DN + (size_t)FF * D;
constexpr size_t WS_HN = WS_W + 2 * WL_EL * 2;
constexpr size_t WS_ZB = WS_HN + (size_t)MT * D * 2;
constexpr size_t WS_BIG = WS_ZB + (size_t)MT * ZBW * 2;
constexpr size_t BIG_QKV = 0, BIG_SU = (size_t)MT * QKVW * 2, BIG_T = BIG_SU + (size_t)2 * NCH * 4 * 16384 * 2;
constexpr size_t WS_END = WS_BIG + (size_t)MT * NGW * 2;
static_assert(BIG_T + (size_t)2 * 4 * 128 * 64 * 128 * 2 <= (size_t)MT * NGW * 2, "BIG region");
static_assert(WS_END <= 268435456, "workspace");
static_assert((size_t)MT * FF * 2 <= WS_END - WS_ZB, "HID overlay");

__device__ __forceinline__ float bflo(unsigned w) { return __uint_as_float(w << 16); }
__device__ __forceinline__ float bfhi(unsigned w) { return __uint_as_float(w & 0xffff0000u); }
__device__ __forceinline__ float bf1(bf16_t v) { return __uint_as_float((unsigned)v << 16); }
typedef float f32x2_t __attribute__((ext_vector_type(2))); typedef __bf16 bf16x2_t __attribute__((ext_vector_type(2)));
__device__ __forceinline__ unsigned pk2(float lo, float hi) { f32x2_t v = {lo, hi}; bf16x2_t b = __builtin_convertvector(v, bf16x2_t); return __builtin_bit_cast(unsigned, b); }
__device__ __forceinline__ bf16_t f2bf(float f) { return (bf16_t)(pk2(f, 0.f) & 0xffffu); }
__device__ __forceinline__ float wave_sum(float v) {
#pragma unroll
    for (int o = 1; o < 64; o <<= 1) v += __shfl_xor(v, o);
    return v;
}
__device__ __forceinline__ f32x4 mfma16(bf16x8 x, bf16x8 y, f32x4 acc) { return __builtin_amdgcn_mfma_f32_16x16x32_bf16(x, y, acc, 0, 0, 0); }
__device__ __forceinline__ bf16x8 lfrag(const LAS bf16_t* base, int row, int stride, int col) { return *(const LAS bf16x8*)(base + row * stride + col); }
__device__ __forceinline__ bf16x8 gfrag(const bf16_t* p) { return *(const bf16x8*)p; }
__device__ __forceinline__ float cos_rev(float r) { return __builtin_amdgcn_cosf(r); }
__device__ __forceinline__ float sin_rev(float r) { return __builtin_amdgcn_sinf(r); }
__device__ __forceinline__ float logsig(float x) { return -log1pf(expf(-x)); }
__device__ __forceinline__ float act_f(float v, int act) {
    if (act == 0) return v;
    if (act == 4) { const float r = fmaxf(v, 0.f); return r * r; }
    const float u = (act == 2) ? 1.5957691216057308f * (v + 0.044715f * v * v * v) : v;
    const float s = __builtin_amdgcn_rcpf(1.f + __expf(-u));
    return act == 3 ? s : v * s;
}


#define XB_TMO      128
#define XB_XCNT(j)  (256  + 64 * (j))
#define XB_XSUB(j)  (1280 + 64 * (j))
#define XB_XGEN(j)  (2304 + 64 * (j))
#define XB_TOP      3328
#define XB_TOPGEN   3392
#define XCD_BAR_WORDS 3456
#define XB_SPIN_CAP (1u << 18)
__device__ __forceinline__ unsigned xb_ld(unsigned* p)              { return __hip_atomic_load(p, __ATOMIC_RELAXED, __HIP_MEMORY_SCOPE_AGENT); }
__device__ __forceinline__ unsigned xb_add(unsigned* p, unsigned v) { return __hip_atomic_fetch_add(p, v, __ATOMIC_RELAXED, __HIP_MEMORY_SCOPE_AGENT); }
__device__ __forceinline__ unsigned xb_xcc_id() { return (unsigned)__builtin_amdgcn_s_getreg((3 << 11) | 20) & 0xFu; }
#define XB_SPIN(cond, bar) do { unsigned _sp = 0; while (cond) { __builtin_amdgcn_s_sleep(1); \
    if ((++_sp & 255u) == 0u) { if (xb_ld(&(bar)[XB_TMO])) break; if (_sp > XB_SPIN_CAP) { atomicAdd(&(bar)[XB_TMO], 1u); break; } } } } while (0)
struct XcdBarrier { unsigned* bar; unsigned x; volatile LAS unsigned* st; };
__device__ __forceinline__ XcdBarrier xcd_barrier_post(unsigned* bar, volatile LAS unsigned* st) {
    XcdBarrier b; b.bar = bar; b.x = xb_xcc_id(); b.st = st;
    if (threadIdx.x == 0) (void)xb_add(&bar[XB_XCNT(b.x)], 1u);
    return b;
}
__device__ __forceinline__ void xcd_barrier_complete(unsigned* bar, unsigned x, unsigned& nloc, unsigned& nx) {
    const unsigned G = gridDim.x * gridDim.y * gridDim.z;
    unsigned sum, cnt, mine, sp = 0u;
    for (;;) {
        sum = 0u; cnt = 0u; mine = 0u;
#pragma unroll
        for (unsigned j = 0; j < 16; ++j) { const unsigned c = xb_ld(&bar[XB_XCNT(j)]); sum += c; cnt += (c > 0u) ? 1u : 0u; mine = (j == x) ? c : mine; }
        if (sum == G) break;
        __builtin_amdgcn_s_sleep(1);
        if ((++sp & 255u) == 0u) { if (xb_ld(&bar[XB_TMO])) break; if (sp > XB_SPIN_CAP) { atomicAdd(&bar[XB_TMO], 1u); break; } }
    }
    nloc = mine > 0u ? mine : 1u; nx = cnt > 0u ? cnt : 1u;
}
__device__ __forceinline__ void xcd_barrier(const XcdBarrier& b) {
    asm volatile("s_waitcnt vmcnt(0)" ::: "memory");
    __syncthreads();
    if (threadIdx.x == 0) {
        unsigned* bar = b.bar;
        __builtin_amdgcn_s_waitcnt(0);
        unsigned nloc = b.st[0], nx = b.st[1];
        if (nloc == 0u) { xcd_barrier_complete(bar, b.x, nloc, nx); b.st[0] = nloc; b.st[1] = nx; }
        const unsigned old = xb_add(&bar[XB_XSUB(b.x)], 1u);
        const unsigned gen = old / nloc;
        if (old + 1u == (gen + 1u) * nloc) {
            __builtin_amdgcn_fence(__ATOMIC_RELEASE, "agent");
            asm volatile("s_waitcnt vmcnt(0)" ::: "memory");
            const unsigned og = xb_add(&bar[XB_TOP], 1u);
            const unsigned tg = og / nx;
            if (og + 1u == (tg + 1u) * nx) xb_add(&bar[XB_TOPGEN], 1u);
            else XB_SPIN(xb_ld(&bar[XB_TOPGEN]) == tg, bar);
            __builtin_amdgcn_fence(__ATOMIC_ACQUIRE, "agent");
            xb_add(&bar[XB_XGEN(b.x)], 1u);
            asm volatile("s_waitcnt vmcnt(0)" ::: "memory");
        } else {
            XB_SPIN(xb_ld(&bar[XB_XGEN(b.x)]) == gen, bar);
            __builtin_amdgcn_fence(__ATOMIC_ACQUIRE, "agent");
            asm volatile("s_waitcnt vmcnt(0)" ::: "memory");
        }
    }
    __syncthreads();
}

namespace pg8 {
constexpr int BM = 256, BK = 64, HALF = 128, HTB = HALF * BK * 2, NXCD = 8, WGM = 8;
__host__ __device__ __forceinline__ int lds_byte(int r, int c) { const int st = (r >> 4) * 2 + (c >> 5), rr = r & 15, cc = c & 31, ob = rr * 64 + cc * 2; return st * 1024 + (ob ^ (((ob >> 9) & 1) << 5)); }
__host__ __device__ __forceinline__ void stage_rc(int b, int& R, int& C) { const int st = b / 1024, sb = b % 1024, swz = sb ^ (((sb >> 9) & 1) << 5); R = (st >> 1) * 16 + swz / 64; C = (st & 1) * 32 + (swz % 64) / 2; }
__host__ __device__ __forceinline__ int perm32(int rho) { const int n = rho >> 4, i = rho & 15; return 8 * (i >> 2) + 4 * n + (i & 3); }
struct Unit { int pm, pn; };
struct Gemm { const bf16_t* A; const bf16_t* Bt; int M, N, K, lda; };
struct StaticOrder {
    int nM, nN, nwg, G, c;
    __device__ void init(int M, int N, int G_, int c_) { nM = M / BM; nN = N / BM; nwg = nM * nN; G = G_; c = c_; }
    __device__ bool next(int i, Unit& u) const {
        const long L = (long)i * G + c; if (L >= nwg) return false;
        int wgid = (int)L; { const int q = nwg / NXCD, r = nwg % NXCD, xcd = wgid % NXCD, off = wgid / NXCD; wgid = (xcd < r ? xcd * (q + 1) : r * (q + 1) + (xcd - r) * q) + off; }
        const int nig = WGM * nN, gid = wgid / nig, fm = gid * WGM, gsz = (nM - fm) < WGM ? (nM - fm) : WGM;
        u.pm = fm + ((wgid % nig) % gsz); u.pn = (wgid % nig) / gsz; return true;
    }
};
__device__ __forceinline__ void store_tile(const f32x4 (&acc)[2][2][4][2], bf16_t* base, int ldc, int rowt, int colt, int act, float sc, int wr, int wc, int fr, int fq) {
    const int row0 = rowt + wr * 64 + fr, col0 = colt + wc * 32 + 8 * fq;
#pragma unroll
    for (int ai = 0; ai < 2; ++ai)
#pragma unroll
        for (int m = 0; m < 4; ++m) { bf16_t* rowp = base + (size_t)(row0 + ai * HALF + m * 16) * ldc + col0;
#pragma unroll
            for (int bj = 0; bj < 2; ++bj) { const f32x4 v0 = acc[ai][bj][m][0] * sc, v1 = acc[ai][bj][m][1] * sc;
                u32x4 w; w.x = pk2(act_f(v0[0], act), act_f(v0[1], act)); w.y = pk2(act_f(v0[2], act), act_f(v0[3], act));
                w.z = pk2(act_f(v1[0], act), act_f(v1[1], act)); w.w = pk2(act_f(v1[2], act), act_f(v1[3], act));
                *(u32x4*)(rowp + bj * HALF) = w; } }
}
struct EpiZ1 {
    static constexpr bool PERM = true, HAS_MID = false;
    bf16_t* qkv; bf16_t* zb;
    __device__ __forceinline__ void mid(f32x4 (&)[2][2][4][2], const Unit&, int, int, int, int, int) const {}
    __device__ __forceinline__ void operator()(const f32x4 (&acc)[2][2][4][2], const Unit& u, int wr, int wc, int fr, int fq) const {
        const int pn = u.pn; bf16_t* base; int ldc, colt, act; float sc = 1.f;
        if (pn < 6) { base = qkv; ldc = QKVW; colt = pn * 256; act = 0; if (pn == 2 || pn == 3) sc = 0.08838834764831845f; }
        else { base = zb; ldc = ZBW; colt = (pn - 6) * 256; act = (pn < 8) ? 1 : (pn == 8 ? 0 : 2); }
        store_tile(acc, base, ldc, u.pm * BM, colt, act, sc, wr, wc, fr, fq);
    }
};
struct EpiAct {
    static constexpr bool PERM = true, HAS_MID = false;
    bf16_t* O; int ldc; int act;
    __device__ __forceinline__ void mid(f32x4 (&)[2][2][4][2], const Unit&, int, int, int, int, int) const {}
    __device__ __forceinline__ void operator()(const f32x4 (&acc)[2][2][4][2], const Unit& u, int wr, int wc, int fr, int fq) const {
        store_tile(acc, O, ldc, u.pm * BM, u.pn * BM, act, 1.f, wr, wc, fr, fq);
    }
};
struct EpiGate {
    static constexpr bool PERM = true, HAS_MID = true;
    const bf16_t* gates; bf16_t* O;
    __device__ __forceinline__ void mid(f32x4 (&acc)[2][2][4][2], const Unit& u, int t, int wr, int wc, int fr, int fq) const {
        const int numofs = (t == 8) ? 0 : 1024;
#pragma unroll
        for (int ai = 0; ai < 2; ++ai)
#pragma unroll
            for (int m = 0; m < 4; ++m) { const bf16_t* gp = gates + (size_t)(u.pm * BM + ai * HALF + wr * 64 + m * 16 + fr) * NGW + u.pn * BM + wc * 32 + 8 * fq + numofs;
#pragma unroll
                for (int bj = 0; bj < 2; ++bj) { const u32x4 nv = *(const u32x4*)(gp + bj * HALF), dv = *(const u32x4*)(gp + bj * HALF + 1024);
#pragma unroll
                    for (int e = 0; e < 4; ++e) { const float n0 = bflo(nv[e]), n1 = bfhi(nv[e]), d0 = bflo(dv[e]), d1 = bfhi(dv[e]);
                        acc[ai][bj][m][e >> 1][(e & 1) * 2] *= n0 * __builtin_amdgcn_rcpf(d0); acc[ai][bj][m][e >> 1][(e & 1) * 2 + 1] *= n1 * __builtin_amdgcn_rcpf(d1); } }
                asm volatile("" ::: "memory"); }
    }
    __device__ __forceinline__ void operator()(const f32x4 (&acc)[2][2][4][2], const Unit& u, int wr, int wc, int fr, int fq) const {
        const int row0 = u.pm * BM + wr * 64 + fr, col0 = u.pn * BM + wc * 32 + 8 * fq;
#pragma unroll
        for (int ai = 0; ai < 2; ++ai)
#pragma unroll
            for (int m = 0; m < 4; ++m) { const size_t r = (size_t)(row0 + ai * HALF + m * 16);
#pragma unroll
                for (int bj = 0; bj < 2; ++bj) { const u32x4 gv = *(const u32x4*)(gates + r * NGW + col0 + bj * HALF + 2048);
                    const f32x4 v0 = acc[ai][bj][m][0], v1 = acc[ai][bj][m][1];
                    u32x4 w; w.x = pk2(v0[0] * bflo(gv[0]), v0[1] * bfhi(gv[0])); w.y = pk2(v0[2] * bflo(gv[1]), v0[3] * bfhi(gv[1]));
                    w.z = pk2(v1[0] * bflo(gv[2]), v1[1] * bfhi(gv[2])); w.w = pk2(v1[2] * bflo(gv[3]), v1[3] * bfhi(gv[3]));
                    *(u32x4*)(O + r * D + col0 + bj * HALF) = w; } }
    }
};

template <class Epi>
__device__ __forceinline__ void gemm_phase(LAS unsigned char* lds, const Gemm g, const StaticOrder& S, const Epi& E) {
    int tid = threadIdx.x; asm volatile("" : "+v"(tid));
    const int wid = __builtin_amdgcn_readfirstlane(tid >> 6), lane = tid & 63, wr = wid >> 2, wc = wid & 3, fr = lane & 15, fq = lane >> 4;
    const int K = g.K, nt = K / BK, lda = g.lda;
    unsigned voffA, voffB;
    { int R, C; stage_rc(tid * 16, R, C); const int Rb = Epi::PERM ? ((R & ~31) + perm32(R & 31)) : R;
        voffA = (unsigned)(R * lda + C) * 2u; voffB = (unsigned)(Rb * K + C) * 2u; }
    const size_t sk_voffA = (size_t)64 * lda * 2, sk_voffB = (size_t)64 * K * 2;
    const size_t kstep = (size_t)(BK * 2);
    const size_t hsA = (size_t)HALF * lda * 2, hsB = (size_t)HALF * K * 2, tsA = 2 * hsA, tsB = 2 * hsB;
    const unsigned ldsw = (unsigned)wid * 1024u;
    const int aoff = lds_byte(wr * 64 + fr, fq * 8), boff = lds_byte(wc * 32 + fr, fq * 8);
#define PG8_SA(b, h) (((b) * 2 + (h)) * HTB)
#define PG8_SB(b, h) ((4 + (b) * 2 + (h)) * HTB)
#define PG8_STAGE(bufoff, gbase, voff) do { _Pragma("unroll") for (int _i = 0; _i < 2; ++_i) \
        __builtin_amdgcn_global_load_lds((const unsigned*)((const char*)(gbase) + (size_t)_i * sk_##voff + (voff)), (LAS unsigned*)(lds + (bufoff) + ldsw + _i * 8192), 16, 0, 0); } while (0)
#define PG8_LDA(dst, b, h) do { _Pragma("unroll") for (int m = 0; m < 4; ++m) _Pragma("unroll") for (int k = 0; k < 2; ++k) dst[m][k] = *(const LAS bf16x8*)(lds + PG8_SA(b, h) + aoff + m * 2048 + k * 1024); } while (0)
#define PG8_LDB(dst, b, h) do { _Pragma("unroll") for (int n = 0; n < 2; ++n) _Pragma("unroll") for (int k = 0; k < 2; ++k) dst[n][k] = *(const LAS bf16x8*)(lds + PG8_SB(b, h) + boff + n * 2048 + k * 1024); } while (0)
#define PG8_MMA(ai, bj, At, Bt) do { __builtin_amdgcn_s_setprio(1); _Pragma("unroll") for (int m = 0; m < 4; ++m) _Pragma("unroll") for (int n = 0; n < 2; ++n) _Pragma("unroll") for (int k = 0; k < 2; ++k) \
        acc[ai][bj][m][n] = __builtin_amdgcn_mfma_f32_16x16x32_bf16(Bt[n][k], At[m][k], acc[ai][bj][m][n], 0, 0, 0); __builtin_amdgcn_s_setprio(0); } while (0)
#define PG8_WAIT_V(n) asm volatile("s_waitcnt vmcnt(" #n ")" ::: "memory")
#define PG8_WAIT_L(n) asm volatile("s_waitcnt lgkmcnt(" #n ")" ::: "memory")
#define PG8_BAR __builtin_amdgcn_s_barrier()
#define PG8_SCHED __builtin_amdgcn_sched_barrier(0)
    Unit cur, nxt; int ui = 0;
    if (!S.next(0, cur)) return;
    f32x4 acc[2][2][4][2];
#pragma unroll
    for (int a = 0; a < 2; ++a)
#pragma unroll
        for (int b = 0; b < 2; ++b)
#pragma unroll
            for (int m = 0; m < 4; ++m)
#pragma unroll
                for (int n = 0; n < 2; ++n) acc[a][b][m][n] = (f32x4){0.f, 0.f, 0.f, 0.f};
    bf16x8 At[4][2], B0[2][2], B1[2][2];
    const char* cA = (const char*)g.A + (size_t)cur.pm * tsA; const char* cB = (const char*)g.Bt + (size_t)cur.pn * tsB;
    PG8_STAGE(PG8_SB(0, 0), cB, voffB); PG8_STAGE(PG8_SB(0, 1), cB + hsB, voffB); PG8_STAGE(PG8_SA(0, 0), cA, voffA); PG8_STAGE(PG8_SA(0, 1), cA + hsA, voffA);
    if (wr == 1) PG8_BAR;
    PG8_WAIT_V(2); PG8_BAR;
    PG8_STAGE(PG8_SB(1, 0), cB + kstep, voffB); PG8_STAGE(PG8_SA(1, 0), cA + kstep, voffA); PG8_STAGE(PG8_SB(1, 1), cB + hsB + kstep, voffB);
    PG8_WAIT_V(6); PG8_BAR;
    for (;;) {
        const bool has_next = S.next(ui + 1, nxt);
        const char* nA = has_next ? (const char*)g.A + (size_t)nxt.pm * tsA : cA; const char* nB = has_next ? (const char*)g.Bt + (size_t)nxt.pn * tsB : cB;
        for (int t = 0; t < nt; t += 2) {
            const bool last = (t == nt - 2);
            const char* a1 = cA + (size_t)(t + 1) * kstep;
            const char* a2 = last ? nA : cA + (size_t)(t + 2) * kstep; const char* b2 = last ? nB : cB + (size_t)(t + 2) * kstep;
            const char* a3 = a2 + kstep; const char* b3 = b2 + kstep;
            if constexpr (Epi::HAS_MID) { if (t == 8 || t == 12) E.mid(acc, cur, t, wr, wc, fr, fq); }
            PG8_LDB(B0, 0, 0); PG8_LDB(B1, 0, 1); PG8_SCHED; PG8_LDA(At, 0, 0); PG8_STAGE(PG8_SA(1, 1), a1 + hsA, voffA);
            PG8_WAIT_V(8); PG8_WAIT_L(0); PG8_BAR; PG8_MMA(0, 0, At, B0); PG8_MMA(0, 1, At, B1); PG8_BAR; PG8_SCHED;
            PG8_LDA(At, 0, 1); PG8_STAGE(PG8_SB(0, 0), b2, voffB); PG8_STAGE(PG8_SB(0, 1), b2 + hsB, voffB); PG8_STAGE(PG8_SA(0, 0), a2, voffA);
            PG8_WAIT_V(8); PG8_WAIT_L(0); PG8_BAR; PG8_MMA(1, 0, At, B0); PG8_MMA(1, 1, At, B1); PG8_BAR; PG8_SCHED;
            PG8_LDB(B0, 1, 0); PG8_LDB(B1, 1, 1); PG8_SCHED; PG8_LDA(At, 1, 0); PG8_STAGE(PG8_SA(0, 1), a2 + hsA, voffA);
            PG8_WAIT_V(8); PG8_WAIT_L(0); PG8_BAR; PG8_MMA(0, 0, At, B0); PG8_MMA(0, 1, At, B1); PG8_BAR; PG8_SCHED;
            PG8_LDA(At, 1, 1); PG8_STAGE(PG8_SB(1, 0), b3, voffB); PG8_STAGE(PG8_SB(1, 1), b3 + hsB, voffB); PG8_STAGE(PG8_SA(1, 0), a3, voffA);
            PG8_WAIT_V(8); PG8_WAIT_L(0); PG8_BAR; PG8_MMA(1, 0, At, B0); PG8_MMA(1, 1, At, B1); PG8_BAR; PG8_SCHED;
        }
        if (wr == 0) PG8_BAR;
        E(acc, cur, wr, wc, fr, fq);
        if (!has_next) break;
#pragma unroll
        for (int a = 0; a < 2; ++a)
#pragma unroll
            for (int b = 0; b < 2; ++b)
#pragma unroll
                for (int m = 0; m < 4; ++m)
#pragma unroll
                    for (int n = 0; n < 2; ++n) acc[a][b][m][n] = (f32x4){0.f, 0.f, 0.f, 0.f};
        cur = nxt; cA = nA; cB = nB; ++ui;
        if (wr == 1) PG8_BAR;
    }
    PG8_WAIT_V(0);
    PG8_BAR;
#undef PG8_SA
#undef PG8_SB
#undef PG8_STAGE
#undef PG8_LDA
#undef PG8_LDB
#undef PG8_MMA
#undef PG8_WAIT_V
#undef PG8_WAIT_L
#undef PG8_BAR
#undef PG8_SCHED
}
}


template <int MODE>
__device__ __forceinline__ void small_gemm_unit(LAS unsigned char* L, const bf16_t* A, int lda, const bf16_t* Bt, int K, bf16_t* O, int ldc, const bf16_t* gates, int unit, int nN32, int tid) {
    asm volatile("" : "+v"(tid));
    const int w = tid >> 6, lane = tid & 63, fr = lane & 15, fq = lane >> 4, wm = w & 1, wk = w >> 1;
    const int rt = unit / nN32, ct = unit - rt * nN32;
    const int r0 = rt * 64 + wm * 32, n0 = ct * 32, kq = K >> 2;
    f32x4 acc[2][2];
#pragma unroll
    for (int a = 0; a < 2; ++a)
#pragma unroll
        for (int b = 0; b < 2; ++b) acc[a][b] = (f32x4){0.f, 0.f, 0.f, 0.f};
    const bf16_t* ap = A + (size_t)(r0 + fr) * lda + wk * kq + fq * 8;
    const bf16_t* bp = Bt + (size_t)(n0 + fr) * K + wk * kq + fq * 8;
#pragma unroll 1
    for (int k0 = 0; k0 < kq; k0 += 256) {
        bf16x8 af[8][2], bfr[8][2];
#pragma unroll
        for (int s = 0; s < 8; ++s) { af[s][0] = gfrag(ap + k0 + s * 32); af[s][1] = gfrag(ap + (size_t)16 * lda + k0 + s * 32);
            bfr[s][0] = gfrag(bp + k0 + s * 32); bfr[s][1] = gfrag(bp + (size_t)16 * K + k0 + s * 32); }
#pragma unroll
        for (int s = 0; s < 8; ++s)
#pragma unroll
            for (int mi = 0; mi < 2; ++mi)
#pragma unroll
                for (int ni = 0; ni < 2; ++ni) acc[mi][ni] = mfma16(bfr[s][ni], af[s][mi], acc[mi][ni]);
    }
    LAS f32x4* red = (LAS f32x4*)L;
#pragma unroll
    for (int t = 0; t < 4; ++t) red[((wk * 2 + wm) * 4 + t) * 64 + lane] = acc[t >> 1][t & 1];
    __syncthreads();
    { const int t = wk, mi = t >> 1, ni = t & 1;
      f32x4 p[4];
#pragma unroll
      for (int q = 0; q < 4; ++q) p[q] = red[((q * 2 + wm) * 4 + t) * 64 + lane];
      const int row = r0 + mi * 16 + fr, col = n0 + ni * 16 + 4 * fq;
      f32x4 v;
      if (MODE == 5) { const bf16_t* gp = gates + (size_t)row * NGW + col; const u32x2 ga = *(const u32x2*)gp, gb = *(const u32x2*)(gp + 1024), gc = *(const u32x2*)(gp + 2048);
          const f32x4 fa = {bflo(ga.x), bfhi(ga.x), bflo(ga.y), bfhi(ga.y)}, fb = {bflo(gb.x), bfhi(gb.x), bflo(gb.y), bfhi(gb.y)}, fc = {bflo(gc.x), bfhi(gc.x), bflo(gc.y), bfhi(gc.y)};
          v = fa * (p[0] + p[1]) + fb * p[2] + fc * p[3]; }
      else { v = (p[0] + p[1]) + (p[2] + p[3]);
#pragma unroll
          for (int e = 0; e < 4; ++e) v[e] = act_f(v[e], MODE); }
      u32x2 o; o.x = pk2(v[0], v[1]); o.y = pk2(v[2], v[3]);
      *(u32x2*)(O + (size_t)row * ldc + col) = o; }
    __syncthreads();
}

__device__ __forceinline__ void tr_item(const float* W, int N, bf16_t* WT, int ldk, int kofs, LAS float* scr, int item, int lane) {
    const int nblk = N / 32, kb = item / nblk, nb = item % nblk, k0 = 64 * kb, n0 = 32 * nb;
#pragma unroll 8
    for (int i = 0; i < 32; ++i) { const int kk = 2 * i + (lane >> 5); scr[kk * 33 + (lane & 31)] = W[(size_t)(k0 + kk) * N + n0 + (lane & 31)]; }
    asm volatile("s_waitcnt lgkmcnt(0)" ::: "memory");
    const int c = lane & 7;
#pragma unroll
    for (int j = 0; j < 4; ++j) { const int n = (lane >> 3) + 8 * j; const LAS float* s = scr + (8 * c) * 33 + n;
        u32x4 o; o.x = pk2(s[0 * 33], s[1 * 33]); o.y = pk2(s[2 * 33], s[3 * 33]); o.z = pk2(s[4 * 33], s[5 * 33]); o.w = pk2(s[6 * 33], s[7 * 33]);
        *(u32x4*)(WT + (size_t)(n0 + n) * ldk + kofs + k0 + 8 * c) = o; }
    asm volatile("s_waitcnt lgkmcnt(0)" ::: "memory");
}

__device__ __forceinline__ void modnorm_store(const f32x4 (&v)[4], const float* gain, const float* sc, const float* sh, bf16_t* orow, int lane) {
    float ss = 0.f;
#pragma unroll
    for (int j = 0; j < 4; ++j) ss += (v[j].x * v[j].x + v[j].y * v[j].y) + (v[j].z * v[j].z + v[j].w * v[j].w);
    const float rstd = 1.0f / sqrtf(wave_sum(ss) * (1.f / D) + EPS);
#pragma unroll
    for (int j = 0; j < 4; ++j) { const int col = 4 * lane + 256 * j;
        const f32x4 g = *(const f32x4*)(gain + col), s1 = *(const f32x4*)(sc + col), s0 = *(const f32x4*)(sh + col);
        const f32x4 h = v[j] * rstd * g * (s1 + 1.0f) + s0;
        u32x2 w; w.x = pk2(h.x, h.y); w.y = pk2(h.z, h.w); *(u32x2*)(orow + col) = w; }
}
__device__ __forceinline__ void row_update(const bf16_t* yrow, const float* xrow, float* xdst, const float* gpost, const float* gate,
                                           const float* gpre, const float* sc, const float* sh, bf16_t* hrow, int lane) {
    f32x4 y[4], x[4]; float ss = 0.f;
#pragma unroll
    for (int j = 0; j < 4; ++j) { const int col = 4 * lane + 256 * j; const u32x2 w = *(const u32x2*)(yrow + col);
        y[j] = (f32x4){bflo(w.x), bfhi(w.x), bflo(w.y), bfhi(w.y)}; x[j] = *(const f32x4*)(xrow + col);
        ss += (y[j].x * y[j].x + y[j].y * y[j].y) + (y[j].z * y[j].z + y[j].w * y[j].w); }
    const float rstd = 1.0f / sqrtf(wave_sum(ss) * (1.f / D) + EPS);
#pragma unroll
    for (int j = 0; j < 4; ++j) { const int col = 4 * lane + 256 * j;
        const f32x4 g = *(const f32x4*)(gpost + col), gt = *(const f32x4*)(gate + col);
        x[j] = x[j] + gt * (y[j] * rstd * g);
#ifdef DBG_SANITIZE
        if (!hrow) { for (int e = 0; e < 4; ++e) if (!(fabsf(x[j][e]) < 1e30f)) x[j][e] = 12345.f; }
#endif
        *(f32x4*)(xdst + col) = x[j]; }
    if (hrow) modnorm_store(x, gpre, sc, sh, hrow, lane);
}

constexpr int LP = 136;
constexpr int LP64 = 72;
constexpr int LPC = 264;
constexpr int TBL_OFF = 106496;

__device__ __forceinline__ int chunk_row0(int ch) { return ch < 128 ? ch * 128 : ML + (ch - 128) * 128; }

__device__ __forceinline__ void unit_rb(LAS unsigned char* L, bf16_t* qkv, bf16_t* su, const float* dlog, int ch, int h, int tid) {
    asm volatile("" : "+v"(tid));
    const bool latent = ch < 128; const int r0 = chunk_row0(ch);
    const float lgf = logsig(dlog[h]), lgb = logsig(dlog[4 + h]);
    LAS bf16_t* KT = (LAS bf16_t*)L; LAS bf16_t* VfT = KT + 128 * LP; LAS bf16_t* VbT = VfT + 128 * LP;
    u32x4 gk[2][2], gq[2][2], gv[4];
#pragma unroll
    for (int it = 0; it < 2; ++it) { const int item = it * NTHR + tid, c = item & 127, d0 = (item >> 7) * 8;
        const bf16_t* rowp = qkv + (size_t)(r0 + c) * QKVW + h * 128 + d0;
        gk[it][0] = *(const u32x4*)(rowp + 512); gk[it][1] = *(const u32x4*)(rowp + 512 + 64);
        if (latent) { gq[it][0] = *(const u32x4*)(rowp); gq[it][1] = *(const u32x4*)(rowp + 64); } else { gq[it][0] = gk[it][0]; gq[it][1] = gk[it][1]; } }
#pragma unroll
    for (int it = 0; it < 4; ++it) { const int item = it * NTHR + tid; gv[it] = *(const u32x4*)(qkv + (size_t)(r0 + (item & 127)) * QKVW + 1024 + h * 128 + (item >> 7) * 8); }
#pragma unroll
    for (int it = 0; it < 2; ++it) {
        const int item = it * NTHR + tid, c = item & 127, dg = item >> 7, d0 = dg * 8;
        bf16_t* rowp = qkv + (size_t)(r0 + c) * QKVW + h * 128 + d0;
        float cs[8], sn[8];
        if (latent) { const int t = (r0 + c) & (SEQ - 1); const float pos = (dg < 4) ? (float)(t >> 6) : (float)(t & 63);
#pragma unroll
            for (int i = 0; i < 8; ++i) { const int jj = (d0 + i) & 31; float rev = pos * __builtin_amdgcn_exp2f(-(float)jj * 0.41524101186092f) * 0.15915494309189535f;
                rev = rev - floorf(rev); cs[i] = cos_rev(rev); sn[i] = sin_rev(rev); } }
        else {
#pragma unroll
            for (int i = 0; i < 8; ++i) { cs[i] = 1.f; sn[i] = 0.f; } }
        {
            const u32x4 lo = gk[it][0], hi = gk[it][1];
            u32x4 wl, wh;
#pragma unroll
            for (int e = 0; e < 4; ++e) { const float a0 = bflo(lo[e]), a1 = bfhi(lo[e]), b0 = bflo(hi[e]), b1 = bfhi(hi[e]);
                wl[e] = pk2(a0 * cs[2 * e] - b0 * sn[2 * e], a1 * cs[2 * e + 1] - b1 * sn[2 * e + 1]);
                wh[e] = pk2(a0 * sn[2 * e] + b0 * cs[2 * e], a1 * sn[2 * e + 1] + b1 * cs[2 * e + 1]); }
            if (latent) { *(u32x4*)(rowp + 512) = wl; *(u32x4*)(rowp + 512 + 64) = wh; }
#pragma unroll
            for (int e = 0; e < 4; ++e) { KT[(d0 + 2 * e) * LP + c] = (bf16_t)(wl[e] & 0xffffu); KT[(d0 + 2 * e + 1) * LP + c] = (bf16_t)(wl[e] >> 16);
                KT[(64 + d0 + 2 * e) * LP + c] = (bf16_t)(wh[e] & 0xffffu); KT[(64 + d0 + 2 * e + 1) * LP + c] = (bf16_t)(wh[e] >> 16); }
        }
        if (latent) {
            const u32x4 lo = gq[it][0], hi = gq[it][1];
            u32x4 wl, wh;
#pragma unroll
            for (int e = 0; e < 4; ++e) { const float a0 = bflo(lo[e]), a1 = bfhi(lo[e]), b0 = bflo(hi[e]), b1 = bfhi(hi[e]);
                wl[e] = pk2(a0 * cs[2 * e] - b0 * sn[2 * e], a1 * cs[2 * e + 1] - b1 * sn[2 * e + 1]);
                wh[e] = pk2(a0 * sn[2 * e] + b0 * cs[2 * e], a1 * sn[2 * e + 1] + b1 * cs[2 * e + 1]); }
            *(u32x4*)(rowp) = wl; *(u32x4*)(rowp + 64) = wh;
        }
    }
#pragma unroll
    for (int it = 0; it < 4; ++it) {
        const int item = it * NTHR + tid, c = item & 127, e0 = (item >> 7) * 8;
        const u32x4 vv = gv[it];
        const float wf = __expf(lgf * (float)(127 - c)), wb = __expf(lgb * (float)c);
#pragma unroll
        for (int e = 0; e < 4; ++e) { const float v0 = bflo(vv[e]), v1 = bfhi(vv[e]);
            VfT[(e0 + 2 * e) * LP + c] = f2bf(v0 * wf); VfT[(e0 + 2 * e + 1) * LP + c] = f2bf(v1 * wf);
            VbT[(e0 + 2 * e) * LP + c] = f2bf(v0 * wb); VbT[(e0 + 2 * e + 1) * LP + c] = f2bf(v1 * wb); }
    }
    __syncthreads();
    const int w = tid >> 6, lane = tid & 63, fr = lane & 15, fq = lane >> 4;
    bf16x8 xk[4];
#pragma unroll
    for (int kk = 0; kk < 4; ++kk) xk[kk] = lfrag(KT, 16 * w + fr, LP, kk * 32 + fq * 8);
#pragma unroll
    for (int dir = 0; dir < 2; ++dir) { const LAS bf16_t* VT = dir ? VbT : VfT;
        bf16_t* sp = su + ((size_t)(dir * NCH + ch) * 4 + h) * 16384;
#pragma unroll
        for (int et = 0; et < 8; ++et) { f32x4 a = {0.f, 0.f, 0.f, 0.f};
#pragma unroll
            for (int kk = 0; kk < 4; ++kk) a = mfma16(xk[kk], lfrag(VT, et * 16 + fr, LP, kk * 32 + fq * 8), a);
            u32x2 o; o.x = pk2(a[0], a[1]); o.y = pk2(a[2], a[3]);
            *(u32x2*)(sp + (et * 16 + fr) * 128 + 16 * w + 4 * fq) = o; } }
    __syncthreads();
}

__device__ __forceinline__ void scan_item(unsigned* su32, const float* dlog, int item, int tid) {
    asm volatile("" : "+v"(tid));
    const int combo = item >> 4, b = combo & 1, h = (combo >> 1) & 3, dir = combo >> 3, sub = item & 15;
    const int idx2 = sub * NTHR + tid;
    const float decay = expf(logsig(dlog[dir * 4 + h]) * 128.f);
    float s0 = 0.f, s1 = 0.f;
#pragma unroll 1
    for (int i0 = 0; i0 < 66; i0 += 6) {
        unsigned uv[6]; size_t off[6];
#pragma unroll
        for (int j = 0; j < 6; ++j) { const int i = i0 + j;
            const int ch = (i < 2) ? (128 + 2 * b + (dir ? 1 - i : i)) : (64 * b + (dir ? 63 - (i - 2) : (i - 2)));
            off[j] = (((size_t)(dir * NCH + ch) * 4 + h) * 16384) / 2 + idx2; uv[j] = su32[off[j]]; }
#pragma unroll
        for (int j = 0; j < 6; ++j) { su32[off[j]] = pk2(s0, s1); s0 = decay * s0 + bflo(uv[j]); s1 = decay * s1 + bfhi(uv[j]); }
    }
}

__device__ __forceinline__ void unit_rd(LAS unsigned char* L, const bf16_t* qkv, bf16_t* zb, const bf16_t* su, const float* dlog, int ch, int h, int tid) {
    asm volatile("" : "+v"(tid));
    const int r0 = chunk_row0(ch);
    const float lgf = logsig(dlog[h]), lgb = logsig(dlog[4 + h]);
    const float lgf2 = lgf * 1.4426950408889634f, lgb2 = lgb * 1.4426950408889634f;
    LAS bf16_t* Ks = (LAS bf16_t*)L; LAS bf16_t* VT = Ks + 128 * LP; LAS bf16_t* Ps = VT + 128 * LP;
    const bf16_t* spf = su + ((size_t)(0 * NCH + ch) * 4 + h) * 16384; const bf16_t* spb = su + ((size_t)(1 * NCH + ch) * 4 + h) * 16384;
    u32x4 kreg[4], vreg[4], sfr[4], sbr[4];
#pragma unroll
    for (int it = 0; it < 4; ++it) { const int item = it * NTHR + tid;
        kreg[it] = *(const u32x4*)(qkv + (size_t)(r0 + (item >> 4)) * QKVW + 512 + h * 128 + (item & 15) * 8);
        vreg[it] = *(const u32x4*)(qkv + (size_t)(r0 + (item & 127)) * QKVW + 1024 + h * 128 + (item >> 7) * 8);
        sfr[it] = *(const u32x4*)(spf + (size_t)item * 8); sbr[it] = *(const u32x4*)(spb + (size_t)item * 8); }
    const int w = tid >> 6, lane = tid & 63, fr = lane & 15, fq = lane >> 4, cc = 16 * w + fr;
    bf16x8 qf[4];
#pragma unroll
    for (int kk = 0; kk < 4; ++kk) qf[kk] = gfrag(qkv + (size_t)(r0 + cc) * QKVW + h * 128 + kk * 32 + fq * 8);
#pragma unroll
    for (int it = 0; it < 4; ++it) { const int item = it * NTHR + tid;
        *(LAS u32x4*)(Ks + (item >> 4) * LP + (item & 15) * 8) = kreg[it];
        const int c = item & 127, e0 = (item >> 7) * 8;
#pragma unroll
        for (int e = 0; e < 4; ++e) { VT[(e0 + 2 * e) * LP + c] = (bf16_t)(vreg[it][e] & 0xffffu); VT[(e0 + 2 * e + 1) * LP + c] = (bf16_t)(vreg[it][e] >> 16); } }
    __syncthreads();
#pragma unroll
    for (int st = 0; st < 8; ++st) { f32x4 a = {0.f, 0.f, 0.f, 0.f};
#pragma unroll
        for (int kk = 0; kk < 4; ++kk) a = mfma16(lfrag(Ks, st * 16 + fr, LP, kk * 32 + fq * 8), qf[kk], a);
        float p[4];
#pragma unroll
        for (int r = 0; r < 4; ++r) { const int diff = cc - (st * 16 + 4 * fq + r);
            const float m = diff >= 0 ? __builtin_amdgcn_exp2f(lgf2 * (float)diff) : __builtin_amdgcn_exp2f(-lgb2 * (float)diff); p[r] = a[r] * m; }
        u32x2 o; o.x = pk2(p[0], p[1]); o.y = pk2(p[2], p[3]);
        *(LAS u32x2*)(Ps + cc * LP + st * 16 + 4 * fq) = o; }
    __syncthreads();
#pragma unroll
    for (int it = 0; it < 4; ++it) { const int item = it * NTHR + tid; *(LAS u32x4*)(Ks + (item >> 4) * LP + (item & 15) * 8) = sfr[it]; }
    bf16x8 pf[4];
#pragma unroll
    for (int kk = 0; kk < 4; ++kk) pf[kk] = lfrag(Ps, cc, LP, kk * 32 + fq * 8);
    f32x4 o[8];
#pragma unroll
    for (int et = 0; et < 8; ++et) { o[et] = (f32x4){0.f, 0.f, 0.f, 0.f};
#pragma unroll
        for (int kk = 0; kk < 4; ++kk) o[et] = mfma16(lfrag(VT, et * 16 + fr, LP, kk * 32 + fq * 8), pf[kk], o[et]); }
    __syncthreads();
#pragma unroll
    for (int it = 0; it < 4; ++it) { const int item = it * NTHR + tid; *(LAS u32x4*)(VT + (item >> 4) * LP + (item & 15) * 8) = sbr[it]; }
    { const float qd = __expf(lgf * (float)(cc + 1));
#pragma unroll
      for (int et = 0; et < 8; ++et) { f32x4 a = {0.f, 0.f, 0.f, 0.f};
#pragma unroll
          for (int kk = 0; kk < 4; ++kk) a = mfma16(lfrag(Ks, et * 16 + fr, LP, kk * 32 + fq * 8), qf[kk], a);
          o[et] += a * qd; } }
    __syncthreads();
    { const float qd = __expf(lgb * (float)(128 - cc));
#pragma unroll
      for (int et = 0; et < 8; ++et) { f32x4 a = {0.f, 0.f, 0.f, 0.f};
#pragma unroll
          for (int kk = 0; kk < 4; ++kk) a = mfma16(lfrag(VT, et * 16 + fr, LP, kk * 32 + fq * 8), qf[kk], a);
          o[et] += a * qd; } }
    float ss = 0.f;
#pragma unroll
    for (int et = 0; et < 8; ++et) ss += (o[et][0] * o[et][0] + o[et][1] * o[et][1]) + (o[et][2] * o[et][2] + o[et][3] * o[et][3]);
    ss += __shfl_xor(ss, 16); ss += __shfl_xor(ss, 32);
    const float rstd = 1.0f / sqrtf(ss * (1.f / 128.f) + EPS);
#pragma unroll
    for (int et = 0; et < 8; ++et) { bf16_t* gp = zb + (size_t)(r0 + cc) * ZBW + h * 128 + et * 16 + 4 * fq;
        const u32x2 gv = *(const u32x2*)gp; u32x2 ov;
        ov.x = pk2(o[et][0] * rstd * bflo(gv.x), o[et][1] * rstd * bfhi(gv.x)); ov.y = pk2(o[et][2] * rstd * bflo(gv.y), o[et][3] * rstd * bfhi(gv.y));
        *(u32x2*)gp = ov; }
    __syncthreads();
}

__device__ __forceinline__ void unit_fa(LAS unsigned char* L, const bf16_t* zb, bf16_t* T, int uidx, int tid) {
    asm volatile("" : "+v"(tid));
    const int b = uidx >> 7, g = (uidx >> 5) & 3, l2b = (uidx & 31) * 4;
    const LAS bf16_t* TC = (const LAS bf16_t*)(L + TBL_OFF); const LAS bf16_t* TS = TC + 64 * LP64; const LAS bf16_t* TN = TS + 64 * LP64;
    const int w = tid >> 6, lane = tid & 63, fr = lane & 15, fq = lane >> 4;
    { const int it = w >> 1, jt0 = 2 * (w & 1);
      bf16x8 xf[4][2];
#pragma unroll
      for (int jb = 0; jb < 4; ++jb) { const bf16_t* xp = zb + (size_t)(b * SEQ + 128 * (it * 16 + fr) + l2b + jb) * ZBW + 512 + g * 64 + fq * 8; xf[jb][0] = gfrag(xp); xf[jb][1] = gfrag(xp + 32); }
#pragma unroll
      for (int jb = 0; jb < 4; ++jb) { LAS bf16_t* ZrT = (LAS bf16_t*)L + jb * 2 * 64 * LP64; LAS bf16_t* ZiT = ZrT + 64 * LP64;
#pragma unroll
        for (int jj = 0; jj < 2; ++jj) { const int jt = jt0 + jj; f32x4 zr = {0.f, 0.f, 0.f, 0.f}, zi = {0.f, 0.f, 0.f, 0.f};
#pragma unroll
          for (int kk = 0; kk < 2; ++kk) { zr = mfma16(xf[jb][kk], lfrag(TC, jt * 16 + fr, LP64, kk * 32 + fq * 8), zr); zi = mfma16(xf[jb][kk], lfrag(TN, jt * 16 + fr, LP64, kk * 32 + fq * 8), zi); }
          u32x2 o; o.x = pk2(zr[0], zr[1]); o.y = pk2(zr[2], zr[3]); *(LAS u32x2*)(ZrT + (jt * 16 + fr) * LP64 + it * 16 + 4 * fq) = o;
          o.x = pk2(zi[0], zi[1]); o.y = pk2(zi[2], zi[3]); *(LAS u32x2*)(ZiT + (jt * 16 + fr) * LP64 + it * 16 + 4 * fq) = o; } } }
    __syncthreads();
    { const int ct = w >> 1, kt0 = 2 * (w & 1);
#pragma unroll
      for (int jb = 0; jb < 4; ++jb) { const LAS bf16_t* ZrT = (const LAS bf16_t*)L + jb * 2 * 64 * LP64; const LAS bf16_t* ZiT = ZrT + 64 * LP64; const int l2 = l2b + jb;
        bf16x8 xr[2], xi[2];
#pragma unroll
        for (int kk = 0; kk < 2; ++kk) { xr[kk] = lfrag(ZrT, ct * 16 + fr, LP64, kk * 32 + fq * 8); xi[kk] = lfrag(ZiT, ct * 16 + fr, LP64, kk * 32 + fq * 8); }
#pragma unroll
        for (int jj = 0; jj < 2; ++jj) { const int kt = kt0 + jj; f32x4 ar = {0.f, 0.f, 0.f, 0.f}, ai = {0.f, 0.f, 0.f, 0.f};
#pragma unroll
          for (int kk = 0; kk < 2; ++kk) { const bf16x8 yc = lfrag(TC, kt * 16 + fr, LP64, kk * 32 + fq * 8), ys = lfrag(TS, kt * 16 + fr, LP64, kk * 32 + fq * 8), yn = lfrag(TN, kt * 16 + fr, LP64, kk * 32 + fq * 8);
              ar = mfma16(xr[kk], yc, ar); ar = mfma16(xi[kk], ys, ar); ai = mfma16(xi[kk], yc, ai); ai = mfma16(xr[kk], yn, ai); }
          const int k1 = kt * 16 + fr; const float fv = (float)((l2 * k1) & 8191) * (1.f / 8192.f); const float tc = cos_rev(fv), ts = sin_rev(fv);
          bf16_t* tp = T + ((size_t)((b * 4 + g) * 128 + l2) * 64 + k1) * 128 + ct * 16 + 4 * fq;
          u32x2 o; o.x = pk2(ar[0] * tc + ai[0] * ts, ar[1] * tc + ai[1] * ts); o.y = pk2(ar[2] * tc + ai[2] * ts, ar[3] * tc + ai[3] * ts); *(u32x2*)tp = o;
          o.x = pk2(ai[0] * tc - ar[0] * ts, ai[1] * tc - ar[1] * ts); o.y = pk2(ai[2] * tc - ar[2] * ts, ai[3] * tc - ar[3] * ts); *(u32x2*)(tp + 64) = o; } } }
    __syncthreads();
}

__device__ __forceinline__ void unit_fb(LAS unsigned char* L, bf16_t* zb, const bf16_t* T, int uidx, int tid) {
    asm volatile("" : "+v"(tid));
    const int b = uidx >> 8, g = (uidx >> 6) & 3, k1 = uidx & 63;
    const LAS bf16_t* Wc = (const LAS bf16_t*)L; const LAS bf16_t* Ws = Wc + 128 * LP;
    LAS bf16_t* ArT = (LAS bf16_t*)L + 2 * 128 * LP; LAS bf16_t* AiT = ArT + 64 * LP;
#pragma unroll
    for (int it = 0; it < 4; ++it) { const int item = it * NTHR + tid, l2 = item >> 4, ck = item & 15;
        const u32x4 vv = *(const u32x4*)(T + ((size_t)((b * 4 + g) * 128 + l2) * 64 + k1) * 128 + ck * 8);
        LAS bf16_t* dst = (ck < 8) ? ArT : AiT; const int c0 = (ck & 7) * 8;
#pragma unroll
        for (int e = 0; e < 4; ++e) { dst[(c0 + 2 * e) * LP + l2] = (bf16_t)(vv[e] & 0xffffu); dst[(c0 + 2 * e + 1) * LP + l2] = (bf16_t)(vv[e] >> 16); } }
    __syncthreads();
    const int w = tid >> 6, lane = tid & 63, fr = lane & 15, fq = lane >> 4;
    bf16x8 yc[4], ys[4];
#pragma unroll
    for (int kk = 0; kk < 4; ++kk) { yc[kk] = lfrag(Wc, 16 * w + fr, LP, kk * 32 + fq * 8); ys[kk] = lfrag(Ws, 16 * w + fr, LP, kk * 32 + fq * 8); }
    const size_t row = (size_t)(b * SEQ + k1 + 64 * (16 * w + fr));
#pragma unroll
    for (int it = 0; it < 4; ++it) { f32x4 a = {0.f, 0.f, 0.f, 0.f};
#pragma unroll
        for (int kk = 0; kk < 4; ++kk) { a = mfma16(lfrag(ArT, it * 16 + fr, LP, kk * 32 + fq * 8), yc[kk], a); a = mfma16(lfrag(AiT, it * 16 + fr, LP, kk * 32 + fq * 8), ys[kk], a); }
        const float sc = 0.0013810679320049757f;
        u32x2 o; o.x = pk2(a[0] * sc, a[1] * sc); o.y = pk2(a[2] * sc, a[3] * sc);
        *(u32x2*)(zb + row * ZBW + 512 + g * 64 + it * 16 + 4 * fq) = o; }
    __syncthreads();
}

__device__ __forceinline__ void unit_fc(LAS unsigned char* L, bf16_t* zb, int uidx, int tid) {
    asm volatile("" : "+v"(tid));
    const int b = uidx >> 2, g = uidx & 3, rb = ML + b * CTXL;
    const LAS bf16_t* TC = (const LAS bf16_t*)(L + TBL_OFF); const LAS bf16_t* TN = TC + 2 * 64 * LP64;
    LAS bf16_t* ZrT = (LAS bf16_t*)L; LAS bf16_t* ZiT = ZrT + 64 * LPC;
    const int w = tid >> 6, lane = tid & 63, fr = lane & 15, fq = lane >> 4;
#pragma unroll
    for (int ii = 0; ii < 2; ++ii) { const int it = 2 * w + ii;
        const bf16_t* xp = zb + (size_t)(rb + it * 16 + fr) * ZBW + 512 + g * 64 + fq * 8;
        bf16x8 xf[2]; xf[0] = gfrag(xp); xf[1] = gfrag(xp + 32);
#pragma unroll
        for (int jt = 0; jt < 4; ++jt) { f32x4 zr = {0.f, 0.f, 0.f, 0.f}, zi = {0.f, 0.f, 0.f, 0.f};
#pragma unroll
            for (int kk = 0; kk < 2; ++kk) { zr = mfma16(xf[kk], lfrag(TC, jt * 16 + fr, LP64, kk * 32 + fq * 8), zr); zi = mfma16(xf[kk], lfrag(TN, jt * 16 + fr, LP64, kk * 32 + fq * 8), zi); }
            u32x2 o; o.x = pk2(zr[0], zr[1]); o.y = pk2(zr[2], zr[3]); *(LAS u32x2*)(ZrT + (jt * 16 + fr) * LPC + it * 16 + 4 * fq) = o;
            o.x = pk2(zi[0], zi[1]); o.y = pk2(zi[2], zi[3]); *(LAS u32x2*)(ZiT + (jt * 16 + fr) * LPC + it * 16 + 4 * fq) = o; } }
    __syncthreads();
#pragma unroll 1
    for (int ii = 0; ii < 2; ++ii) { const int lp = (2 * w + ii) * 16 + fr;
        f32x4 a[4];
#pragma unroll
        for (int i2 = 0; i2 < 4; ++i2) a[i2] = (f32x4){0.f, 0.f, 0.f, 0.f};
#pragma unroll 1
        for (int kk = 0; kk < 8; ++kk) { u32x4 cw, sw;
#pragma unroll
            for (int e = 0; e < 4; ++e) { const int l0 = kk * 32 + fq * 8 + 2 * e; const float f0 = (float)((l0 * lp) & 255) * (1.f / 256.f), f1 = (float)(((l0 + 1) * lp) & 255) * (1.f / 256.f);
                cw[e] = pk2(cos_rev(f0), cos_rev(f1)); sw[e] = pk2(sin_rev(f0), sin_rev(f1)); }
            const bf16x8 yc = __builtin_bit_cast(bf16x8, cw), ys = __builtin_bit_cast(bf16x8, sw);
#pragma unroll
            for (int i2 = 0; i2 < 4; ++i2) { a[i2] = mfma16(lfrag(ZrT, i2 * 16 + fr, LPC, kk * 32 + fq * 8), yc, a[i2]); a[i2] = mfma16(lfrag(ZiT, i2 * 16 + fr, LPC, kk * 32 + fq * 8), ys, a[i2]); } }
#pragma unroll
        for (int i2 = 0; i2 < 4; ++i2) { u32x2 o; o.x = pk2(a[i2][0] * 0.0078125f, a[i2][1] * 0.0078125f); o.y = pk2(a[i2][2] * 0.0078125f, a[i2][3] * 0.0078125f);
            *(u32x2*)(zb + (size_t)(rb + lp) * ZBW + 512 + g * 64 + i2 * 16 + 4 * fq) = o; } }
    __syncthreads();
}

__device__ __forceinline__ void unit_sgu(LAS unsigned char* L, bf16_t* zb, const float* ws, const float* bs, const float* gn, int ch, int g, int tid) {
    asm volatile("" : "+v"(tid));
    const int r0 = chunk_row0(ch);
    LAS bf16_t* VT = (LAS bf16_t*)L;
#pragma unroll
    for (int it = 0; it < 2; ++it) { const int item = it * NTHR + tid, row = item >> 3, ck = item & 7;
        const u32x4 vv = *(const u32x4*)(zb + (size_t)(r0 + row) * ZBW + 1024 + g * 64 + ck * 8);
        float f[8]; float ss = 0.f;
#pragma unroll
        for (int e = 0; e < 4; ++e) { f[2 * e] = bflo(vv[e]); f[2 * e + 1] = bfhi(vv[e]); ss += f[2 * e] * f[2 * e] + f[2 * e + 1] * f[2 * e + 1]; }
        ss += __shfl_xor(ss, 1); ss += __shfl_xor(ss, 2); ss += __shfl_xor(ss, 4);
        const float rstd = 1.0f / sqrtf(ss * (1.f / 64.f) + EPS);
#pragma unroll
        for (int i = 0; i < 8; ++i) VT[(ck * 8 + i) * LP + row] = f2bf(f[i] * rstd * gn[g * 64 + ck * 8 + i]); }
    __syncthreads();
    const int w = tid >> 6, lane = tid & 63, fr = lane & 15, fq = lane >> 4, t = 16 * w + fr;
    bf16x8 yw[4];
#pragma unroll
    for (int kk = 0; kk < 4; ++kk) { const float* wp = ws + (size_t)(g * 128 + t) * 128 + kk * 32 + fq * 8; const f32x4 a = *(const f32x4*)wp, b = *(const f32x4*)(wp + 4);
        u32x4 pw; pw.x = pk2(a.x, a.y); pw.y = pk2(a.z, a.w); pw.z = pk2(b.x, b.y); pw.w = pk2(b.z, b.w); yw[kk] = __builtin_bit_cast(bf16x8, pw); }
    const float bias = bs[g * 128 + t];
#pragma unroll
    for (int it = 0; it < 4; ++it) { f32x4 a = {0.f, 0.f, 0.f, 0.f};
#pragma unroll
        for (int kk = 0; kk < 4; ++kk) a = mfma16(lfrag(VT, it * 16 + fr, LP, kk * 32 + fq * 8), yw[kk], a);
        bf16_t* up = zb + (size_t)(r0 + t) * ZBW + 768 + g * 64 + it * 16 + 4 * fq;
        const u32x2 uv = *(const u32x2*)up; u32x2 o;
        o.x = pk2(bflo(uv.x) * (a[0] + bias), bfhi(uv.x) * (a[1] + bias)); o.y = pk2(bflo(uv.y) * (a[2] + bias), bfhi(uv.y) * (a[3] + bias));
        *(u32x2*)up = o; }
    __syncthreads();
}


#ifdef DBG_NANSCAN
__device__ __forceinline__ bool dbg_scan_rg(const unsigned char* base, size_t bytes, bool f32, int gtid, int gn) {
    const unsigned* p = (const unsigned*)base; const size_t n = bytes / 4; bool bad = false;
    for (size_t i = gtid; i < n; i += gn) { const unsigned v = p[i]; if (f32) { if ((v & 0x7F800000u) == 0x7F800000u) bad = true; } else if ((v & 0x7F80u) == 0x7F80u || (v & 0x7F800000u) == 0x7F800000u) bad = true; }
    return bad;
}
__device__ __forceinline__ bool dbg_huge_rg(const unsigned char* base, size_t bytes, bool f32, int gtid, int gn) {
    const unsigned* p = (const unsigned*)base; const size_t n = bytes / 4; bool bad = false;
    for (size_t i = gtid; i < n; i += gn) { const unsigned v = p[i]; if ((v & 0x7F800000u) >= 0x44800000u) bad = true; if (!f32 && (v & 0x7F80u) >= 0x4480u) bad = true; }
    return bad;
}
__device__ __forceinline__ void dbg_scan(unsigned char* ws, int code, int k0only, int gtid, int gn) {
    unsigned* flag = (unsigned*)ws; bool bad = false;
    { unsigned m = 0;
      if (code == 0) { if (dbg_huge_rg(ws + WS_MOD, 147456, true, gtid, gn)) m |= 1u; if (dbg_huge_rg(ws + WS_W, WS_HN - WS_W, false, gtid, gn)) m |= 2u; }
      if (code == 1) { if (dbg_huge_rg(ws + WS_HN, (size_t)MT * D * 2, false, gtid, gn)) m |= 4u; }
      if (code == 2) { if (dbg_huge_rg(ws + WS_BIG, BIG_SU, false, gtid, gn)) m |= 8u; if (dbg_huge_rg(ws + WS_ZB, (size_t)MT * ZBW * 2, false, gtid, gn)) m |= 16u; }
      if (m) atomicOr(flag + 1, m); }
    const int ph = code < 2 ? code : 2 + (code - 2) % 11;
    const size_t HNB = (size_t)MT * D * 2, ZBB = (size_t)MT * ZBW * 2, BIGB = (size_t)MT * NGW * 2;
    if (ph == 0) { bad |= dbg_scan_rg(ws + WS_MOD, 147456, true, gtid, gn); bad |= dbg_scan_rg(ws + WS_W, WS_HN - WS_W, false, gtid, gn); }
    else if (ph == 1 || ph == 7 || ph == 9 || ph == 11 || ph == 12) bad |= dbg_scan_rg(ws + WS_HN, HNB, false, gtid, gn);
    else if (ph == 2) { bad |= dbg_scan_rg(ws + WS_ZB, ZBB, false, gtid, gn); bad |= dbg_scan_rg(ws + WS_BIG, BIG_SU, false, gtid, gn); }
    else if (ph == 3) { unsigned m = 0;
        if (dbg_scan_rg(ws + WS_ZB, (size_t)ML * ZBW * 2, false, gtid, gn)) m |= 1u;
        if (dbg_scan_rg(ws + WS_ZB + (size_t)ML * ZBW * 2, (size_t)MC * ZBW * 2, false, gtid, gn)) m |= 2u;
        if (dbg_scan_rg(ws + WS_BIG, BIG_SU, false, gtid, gn)) m |= 4u;
        if (dbg_scan_rg(ws + WS_BIG + BIG_SU, BIG_T - BIG_SU, false, gtid, gn)) m |= 8u;
        if (dbg_scan_rg(ws + WS_BIG + BIG_T, 16777216, false, gtid, gn)) m |= 16u;
        bad = m != 0; }
    else if (ph == 4) { bad |= dbg_scan_rg(ws + WS_ZB, ZBB, false, gtid, gn); bad |= dbg_scan_rg(ws + WS_BIG + BIG_SU, BIG_T - BIG_SU, false, gtid, gn); }
    else if (ph == 5) bad |= dbg_scan_rg(ws + WS_ZB, ZBB, false, gtid, gn);
    else if (ph == 6) bad |= dbg_scan_rg(ws + WS_BIG, BIGB, false, gtid, gn);
    else if (ph == 8) bad |= dbg_scan_rg(ws + WS_BIG, HNB, false, gtid, gn);
    else if (ph == 10) bad |= dbg_scan_rg(ws + WS_ZB, (size_t)MT * FF * 2, false, gtid, gn);
    if (bad) atomicMin(flag, (unsigned)code);
}
#endif
#ifdef PROBE_B
#define PROBE_G2(x) x
#else
#define PROBE_G2(x)
#endif
struct Args { const float* in[21]; float* out; unsigned char* ws; int ph_lo, ph_hi; };
constexpr int NPHASE = 24;

__global__ void __launch_bounds__(NTHR, 2) fwd_kernel(Args args) {
    extern __shared__ __attribute__((aligned(16))) unsigned char lds_raw[];
    LAS unsigned char* L = (LAS unsigned char*)lds_raw;
    cg::grid_group grid = cg::this_grid();
    const int wave = __builtin_amdgcn_readfirstlane((int)threadIdx.x >> 6);
#define FRESH_TID int tid = (int)threadIdx.x; asm volatile("" : "+v"(tid)); const int lane = tid & 63; (void)lane;
    const int G = gridDim.x, bx = blockIdx.x;
    const int gw = bx * NWAVES + wave, NGWV = G * NWAVES;
    unsigned char* ws = args.ws;
    float* MOD = (float*)(ws + WS_MOD); float* CTXS = (float*)(ws + WS_CTXS);
    bf16_t* WB = (bf16_t*)(ws + WS_W); bf16_t* HN = (bf16_t*)(ws + WS_HN); bf16_t* ZB = (bf16_t*)(ws + WS_ZB);
    bf16_t* QKV = (bf16_t*)(ws + WS_BIG + BIG_QKV); bf16_t* SU = (bf16_t*)(ws + WS_BIG + BIG_SU); bf16_t* TT = (bf16_t*)(ws + WS_BIG + BIG_T);
    bf16_t* GATES = (bf16_t*)(ws + WS_BIG); bf16_t* YB = (bf16_t*)(ws + WS_BIG); bf16_t* HID = (bf16_t*)(ws + WS_ZB);
    const float* x_in = args.in[0]; const float* ctx_in = args.in[2]; float* xout = args.out;
    const int lo = args.ph_lo, hi = args.ph_hi;
    volatile LAS unsigned* xst = (volatile LAS unsigned*)(L + LDS_BYTES - 64);
    if (threadIdx.x < 2) xst[threadIdx.x] = 0u;
    __syncthreads();
    XcdBarrier xbar = xcd_barrier_post((unsigned*)(ws + 4096), xst);
    if (hi - lo > 1) grid.sync();
#ifdef DBG_NANSCAN
    if (bx == 0 && threadIdx.x == 0) { __hip_atomic_store((unsigned*)ws, 0xFFFFFFFFu, __ATOMIC_RELAXED, __HIP_MEMORY_SCOPE_AGENT); __hip_atomic_store((unsigned*)ws + 1, 0u, __ATOMIC_RELAXED, __HIP_MEMORY_SCOPE_AGENT); }
#endif
#define PH(k) (lo <= (k) && (k) < hi)
#ifdef DBG_NANSCAN
#define DBGSCAN(k) do { int t_ = (int)threadIdx.x; asm volatile("" : "+v"(t_)); dbg_scan(ws, (k), (k) == 0, bx * NTHR + t_, G * NTHR); } while (0)
#else
#define DBGSCAN(k)
#endif
#define CG_SYNC() do { __builtin_amdgcn_fence(__ATOMIC_RELEASE, "agent"); asm volatile("s_waitcnt vmcnt(0) lgkmcnt(0)" ::: "memory"); grid.sync(); __builtin_amdgcn_fence(__ATOMIC_ACQUIRE, "agent"); asm volatile("s_waitcnt vmcnt(0)" ::: "memory"); } while (0)
#ifdef PROBE_A
#define PROBE_SYNC2(k) xcd_barrier(xbar);
#else
#define PROBE_SYNC2(k)
#endif
#define SEAM(k) do { if (PH(k) && PH((k) + 1)) { xcd_barrier(xbar); PROBE_SYNC2(k) DBGSCAN(k); } } while (0)

    if (PH(0)) {
        FRESH_TID
        if (bx < 192) {
            LAS float* scv = (LAS float*)L;
            LAS float* red = scv + 3 * 1024;
            for (int i = tid; i < 3 * 1024; i += NTHR) { const float c = (i < 2048) ? args.in[1][i] : args.in[3][i - 2048]; scv[i] = c / (1.f + __expf(-c)); }
            __syncthreads();
            for (int it = bx; it < 192; it += G) { const int l = it / 96, n0 = (it % 96) * 64;
                const float* wp = args.in[4] + ((size_t)l * D + wave * 128) * 6144 + n0 + lane;
                float a0 = 0.f, a1 = 0.f, a2 = 0.f;
#pragma unroll 8
                for (int k = 0; k < 128; ++k) { const float wv = wp[(size_t)k * 6144]; const int kk = wave * 128 + k; a0 += scv[kk] * wv; a1 += scv[1024 + kk] * wv; a2 += scv[2048 + kk] * wv; }
                red[(wave * 3 + 0) * 64 + lane] = a0; red[(wave * 3 + 1) * 64 + lane] = a1; red[(wave * 3 + 2) * 64 + lane] = a2;
                __syncthreads();
                if (tid < 192) { const int slot = tid >> 6, n = tid & 63; float s = args.in[5][l * 6144 + n0 + n];
#pragma unroll
                    for (int w8 = 0; w8 < 8; ++w8) s += red[(w8 * 3 + slot) * 64 + n];
                    MOD[(size_t)(l * 3 + slot) * 6144 + n0 + n] = s; }
                __syncthreads(); }
        }
        __syncthreads();
        LAS float* scr = (LAS float*)(L + wave * 8448);
        constexpr int C0 = 2944, C1 = C0 + 256, C2 = C1 + 128, C3 = C2 + 128, C4 = C3 + 512, C5 = C4 + 2048, C6 = C5 + 2048;
        for (int it = gw; it < 2 * C6; it += NGWV) { const int l = it / C6; int r = it % C6; bf16_t* wl = WB + (size_t)l * WL_EL;
            if (r < C0) tr_item(args.in[10] + (size_t)l * D * INW, INW, wl + WL_IN, D, 0, scr, r, lane);
            else if (r < C1) tr_item(args.in[15] + (size_t)l * 512 * D, D, wl + WL_CAT, D, 0, scr, r - C0, lane);
            else if (r < C2) tr_item(args.in[16] + (size_t)l * 256 * D, D, wl + WL_CAT, D, 512, scr, r - C1, lane);
            else if (r < C3) tr_item(args.in[17] + (size_t)l * 256 * D, D, wl + WL_CAT, D, 768, scr, r - C2, lane);
            else if (r < C4) tr_item(args.in[18] + (size_t)l * D * D, D, wl + WL_O, D, 0, scr, r - C3, lane);
            else if (r < C5) tr_item(args.in[19] + (size_t)l * D * FF, FF, wl + WL_UP, D, 0, scr, r - C4, lane);
            else tr_item(args.in[20] + (size_t)l * FF * D, D, wl + WL_DN, FF, 0, scr, r - C5, lane); }
    }
    SEAM(0);
    if (PH(1)) {
        FRESH_TID
        for (int r = gw; r < MT; r += NGWV) { const float* xr = r < ML ? x_in + (size_t)r * D : ctx_in + (size_t)(r - ML) * D;
            const int slot = r < SEQ ? 0 : (r < ML ? 1 : 2); const float* md = MOD + (size_t)slot * 6144;
            f32x4 v[4];
#pragma unroll
            for (int j = 0; j < 4; ++j) v[j] = *(const f32x4*)(xr + 4 * lane + 256 * j);
            modnorm_store(v, args.in[6], md + 1024, md, HN + (size_t)r * D, lane); }
    }
    SEAM(1);

#pragma unroll 1
    for (int l = 0; l < 2; ++l) {
        const int P = 2 + 11 * l; const bool last = (l == 1);
        const bf16_t* wl = WB + (size_t)l * WL_EL;
        const float* dlog = args.in[11] + l * 8;
        const int Mrows = last ? ML : MT;
        if (PH(P + 0)) { pg8::Gemm g{HN, wl + WL_IN, MT, N1W, D, D}; pg8::StaticOrder S; S.init(MT, N1W, G, bx);
            pg8::EpiZ1 E{QKV, ZB}; pg8::gemm_phase<pg8::EpiZ1>(L, g, S, E); PROBE_G2(pg8::gemm_phase<pg8::EpiZ1>(L, g, S, E)); }
        SEAM(P + 0);
        if (PH(P + 1)) {
            FRESH_TID
            { LAS bf16_t* TC = (LAS bf16_t*)(L + TBL_OFF);
              for (int i = tid; i < 4096; i += NTHR) { const int k = i >> 6, n = i & 63; const float fv = (float)((k * n) & 63) * (1.f / 64.f); const float c = cos_rev(fv), s = sin_rev(fv);
                  TC[k * LP64 + n] = f2bf(c); TC[64 * LP64 + k * LP64 + n] = f2bf(s); TC[2 * 64 * LP64 + k * LP64 + n] = f2bf(-s); } }
            __syncthreads();
            const int nRB = NCH * 4, nSG = (last ? 128 : NCH) * 4, nFA = 256, nFC = last ? 0 : 8;
            for (int it = bx; it < nRB + nSG + nFA + nFC; it += G) {
                if (it < nRB) unit_rb(L, QKV, SU, dlog, it >> 2, it & 3, tid);
                else if (it < nRB + nSG) { const int u = it - nRB; unit_sgu(L, ZB, args.in[12] + (size_t)l * 4 * 128 * 128, args.in[13] + l * 512, args.in[14] + l * 256, u >> 2, u & 3, tid); }
                else if (it < nRB + nSG + nFA) unit_fa(L, ZB, TT, it - nRB - nSG, tid);
                else unit_fc(L, ZB, it - nRB - nSG - nFA, tid);
            }
        }
        SEAM(P + 1);
        if (PH(P + 2)) {
            FRESH_TID
            { LAS bf16_t* Wc = (LAS bf16_t*)L;
              for (int i = tid; i < 16384; i += NTHR) { const int k = i >> 7, n = i & 127; const float fv = (float)((k * n) & 127) * (1.f / 128.f);
                  Wc[k * LP + n] = f2bf(cos_rev(fv)); Wc[128 * LP + k * LP + n] = f2bf(sin_rev(fv)); } }
            __syncthreads();
            for (int it = bx; it < 256 + 512; it += G) {
                if (it < 256) scan_item((unsigned*)SU, dlog, it, tid);
                else unit_fb(L, ZB, TT, it - 256, tid);
            }
        }
        SEAM(P + 2);
        if (PH(P + 3)) { FRESH_TID const int nRD = (last ? 128 : NCH) * 4;
            for (int it = bx; it < nRD; it += G) unit_rd(L, QKV, ZB, SU, dlog, it >> 2, it & 3, tid); }
        SEAM(P + 3);
        if (PH(P + 4)) { { pg8::Gemm g{HN, wl + WL_IN + (size_t)N1W * D, ML, NGW, D, D}; pg8::StaticOrder S; S.init(ML, NGW, G, bx);
              pg8::EpiAct E{GATES, NGW, 3}; pg8::gemm_phase<pg8::EpiAct>(L, g, S, E); }
            if (!last) { FRESH_TID for (int u = bx; u < 8 * 96; u += G) small_gemm_unit<3>(L, HN + (size_t)ML * D, D, wl + WL_IN + (size_t)N1W * D, D, GATES + (size_t)ML * NGW, NGW, nullptr, u, 96, tid); } }
        SEAM(P + 4);
        if (PH(P + 5)) { { pg8::Gemm g{ZB, wl + WL_CAT, ML, D, D, ZBW}; pg8::StaticOrder S; S.init(ML, D, G, bx);
              pg8::EpiGate E{GATES, HN}; pg8::gemm_phase<pg8::EpiGate>(L, g, S, E); }
            if (!last) { FRESH_TID for (int u = bx; u < 8 * 32; u += G) small_gemm_unit<5>(L, ZB + (size_t)ML * ZBW, ZBW, wl + WL_CAT, D, HN + (size_t)ML * D, D, GATES + (size_t)ML * NGW, u, 32, tid); } }
        SEAM(P + 5);
        if (PH(P + 6)) { { pg8::Gemm g{HN, wl + WL_O, ML, D, D, D}; pg8::StaticOrder S; S.init(ML, D, G, bx);
              pg8::EpiAct E{YB, D, 0}; pg8::gemm_phase<pg8::EpiAct>(L, g, S, E); }
            if (!last) { FRESH_TID for (int u = bx; u < 8 * 32; u += G) small_gemm_unit<0>(L, HN + (size_t)ML * D, D, wl + WL_O, D, YB + (size_t)ML * D, D, nullptr, u, 32, tid); } }
        SEAM(P + 6);
        if (PH(P + 7)) {
            FRESH_TID
            for (int r = gw; r < Mrows; r += NGWV) { const bool lat = r < ML;
                const float* xs = lat ? (l == 0 ? x_in + (size_t)r * D : xout + (size_t)r * D) : (l == 0 ? ctx_in + (size_t)(r - ML) * D : CTXS + (size_t)(r - ML) * D);
                float* xd = lat ? xout + (size_t)r * D : CTXS + (size_t)(r - ML) * D;
                const int slot = r < SEQ ? 0 : (r < ML ? 1 : 2); const float* md = MOD + (size_t)(l * 3 + slot) * 6144;
                row_update(YB + (size_t)r * D, xs, xd, args.in[7] + l * D, md + 2048, args.in[8] + l * D, md + 4096, md + 3072, HN + (size_t)r * D, lane); }
        }
        SEAM(P + 7);
        if (PH(P + 8)) { { pg8::Gemm g{HN, wl + WL_UP, ML, FF, D, D}; pg8::StaticOrder S; S.init(ML, FF, G, bx);
              pg8::EpiAct E{HID, FF, 4}; pg8::gemm_phase<pg8::EpiAct>(L, g, S, E); }
            if (!last) { FRESH_TID for (int u = bx; u < 8 * 128; u += G) small_gemm_unit<4>(L, HN + (size_t)ML * D, D, wl + WL_UP, D, HID + (size_t)ML * FF, FF, nullptr, u, 128, tid); } }
        SEAM(P + 8);
        if (PH(P + 9)) { { pg8::Gemm g{HID, wl + WL_DN, ML, D, FF, FF}; pg8::StaticOrder S; S.init(ML, D, G, bx);
              pg8::EpiAct E{HN, D, 0}; pg8::gemm_phase<pg8::EpiAct>(L, g, S, E); }
            if (!last) { FRESH_TID for (int u = bx; u < 8 * 32; u += G) small_gemm_unit<0>(L, HID + (size_t)ML * FF, FF, wl + WL_DN, FF, HN + (size_t)ML * D, D, nullptr, u, 32, tid); } }
        SEAM(P + 9);
        if (PH(P + 10)) {
            FRESH_TID
            for (int r = gw; r < Mrows; r += NGWV) { const bool lat = r < ML;
                float* xd = lat ? xout + (size_t)r * D : CTXS + (size_t)(r - ML) * D;
                const int slot = r < SEQ ? 0 : (r < ML ? 1 : 2); const float* md = MOD + (size_t)(l * 3 + slot) * 6144;
                const float* mdn = MOD + (size_t)(3 + slot) * 6144;
                row_update(HN + (size_t)r * D, xd, xd, args.in[9] + l * D, md + 5120, args.in[6] + D, mdn + 1024, mdn, last ? nullptr : HN + (size_t)r * D, lane); }
        }
        if (!last) SEAM(P + 10);
    }
#ifdef DBG_NANSCAN
    DBGSCAN(23);
    __builtin_amdgcn_fence(__ATOMIC_RELEASE, "agent"); asm volatile("s_waitcnt vmcnt(0) lgkmcnt(0)" ::: "memory"); grid.sync(); __builtin_amdgcn_fence(__ATOMIC_ACQUIRE, "agent");
    { const unsigned fl = __hip_atomic_load((unsigned*)ws, __ATOMIC_RELAXED, __HIP_MEMORY_SCOPE_AGENT);
      for (size_t i = (size_t)bx * NTHR + threadIdx.x; i < (size_t)ML * D; i += (size_t)G * NTHR) xout[i] = (i == 0) ? 1000.f * (float)(__hip_atomic_load((unsigned*)ws + 1, __ATOMIC_RELAXED, __HIP_MEMORY_SCOPE_AGENT) + 1u) + 0.f * (float)fl : 0.f; }
#endif
#undef PH
#undef SEAM
#undef FRESH_TID
}

#ifndef MK_PER_PHASE
#define MK_PER_PHASE 0
#endif
extern "C" void kernel_launch(void* const* d_in, const int* in_sizes, int n_in, void* d_out, int out_size, void* d_ws, size_t ws_size, hipStream_t stream) {
    static int grid = 0;
    if (grid == 0) {
        if (n_in != 21 || ws_size < WS_END) { fprintf(stderr, "kernel_launch: unexpected n_in %d / ws_size %zu (need %zu)\n", n_in, ws_size, (size_t)WS_END); grid = -1; return; }
        int dev = 0, cus = 0, per_cu = 0;
        hipGetDevice(&dev); hipDeviceGetAttribute(&cus, hipDeviceAttributeMultiprocessorCount, dev);
        if (hipFuncSetAttribute((const void*)fwd_kernel, hipFuncAttributeMaxDynamicSharedMemorySize, LDS_BYTES) != hipSuccess) { fprintf(stderr, "kernel_launch: hipFuncSetAttribute failed\n"); grid = -1; return; }
        if (hipOccupancyMaxActiveBlocksPerMultiprocessor(&per_cu, (const void*)fwd_kernel, NTHR, LDS_BYTES) != hipSuccess || per_cu < 1) { fprintf(stderr, "kernel_launch: occupancy query failed (%d)\n", per_cu); (void)hipGetLastError(); per_cu = 1; }
        if (per_cu > 1) per_cu = 1;
        grid = cus * per_cu;
    }
    if (grid < 0) return;
    if (hipMemsetAsync(d_ws, 0, 65536, stream) != hipSuccess) { fprintf(stderr, "kernel_launch: memset failed\n"); return; }
    Args a{};
    for (int i = 0; i < 21; ++i) a.in[i] = (const float*)d_in[i];
    a.out = (float*)d_out; a.ws = (unsigned char*)d_ws;
#if MK_PER_PHASE
    for (int p = 0; p < NPHASE; ++p) { a.ph_lo = p; a.ph_hi = p + 1; hipLaunchKernelGGL(fwd_kernel, dim3(grid), dim3(NTHR), LDS_BYTES, stream, a); }
#else
    a.ph_lo = 0; a.ph_hi = NPHASE;
    void* kargs[] = {&a};
    hipError_t e = hipLaunchCooperativeKernel((const void*)fwd_kernel, dim3(grid), dim3(NTHR), kargs, LDS_BYTES, stream);
    if (e != hipSuccess) fprintf(stderr, "kernel_launch: cooperative launch failed: %s (grid %d)\n", hipGetErrorString(e), grid);
#endif
}
```

```cpp
#include <hip/hip_runtime.h>
#include <hip/hip_cooperative_groups.h>
#include <cstdio>
#include <cstdint>
namespace cg = cooperative_groups;

#define LAS __attribute__((address_space(3)))
typedef unsigned short bf16_t;
typedef short bf16x8 __attribute__((ext_vector_type(8)));
typedef float f32x4 __attribute__((ext_vector_type(4)));
typedef unsigned u32x4 __attribute__((ext_vector_type(4)));
typedef unsigned u32x2 __attribute__((ext_vector_type(2)));

constexpr int D = 1024, SEQ = 8192, NB = 2, ML = NB * SEQ, CTXL = 256, MC = NB * CTXL, MT = ML + MC;
constexpr int INW = 5888, N1W = 2816, NGW = 3072, FF = 4096;
constexpr int QKVW = 1536, ZBW = 1280;
constexpr int NCH = MT / 128;
constexpr float EPS = 1e-6f;
constexpr int NTHR = 512, NWAVES = 8;
constexpr int LDS_BYTES = 147456;

constexpr size_t WS_MOD = 65536;
constexpr size_t WS_CTXS = 262144;
constexpr size_t WS_W = 2359296;
constexpr size_t WL_IN = 0, WL_CAT = (size_t)INW * D, WL_O = WL_CAT + (size_t)D * D, WL_UP = WL_O + (size_t)D * D, WL_DN = WL_UP + (size_t)FF * D, WL_EL = WL_DN + (size_t)FF * D;
constexpr size_t WS_HN = WS_W + 2 * WL_EL * 2;
constexpr size_t WS_ZB = WS_HN + (size_t)MT * D * 2;
constexpr size_t WS_BIG = WS_ZB + (size_t)MT * ZBW * 2;
constexpr size_t BIG_QKV = 0, BIG_SU = (size_t)MT * QKVW * 2, BIG_T = BIG_SU + (size_t)2 * NCH * 4 * 16384 * 2;
constexpr size_t WS_END = WS_BIG + (size_t)MT * NGW * 2;
static_assert(BIG_T + (size_t)2 * 4 * 128 * 64 * 128 * 2 <= (size_t)MT * NGW * 2, "BIG region");
static_assert(WS_END <= 268435456, "workspace");
static_assert((size_t)MT * FF * 2 <= WS_END - WS_ZB, "HID overlay");

__device__ __forceinline__ float bflo(unsigned w) { return __uint_as_float(w << 16); }
__device__ __forceinline__ float bfhi(unsigned w) { return __uint_as_float(w & 0xffff0000u); }
__device__ __forceinline__ float bf1(bf16_t v) { return __uint_as_float((unsigned)v << 16); }
typedef float f32x2_t __attribute__((ext_vector_type(2))); typedef __bf16 bf16x2_t __attribute__((ext_vector_type(2)));
__device__ __forceinline__ unsigned pk2(float lo, float hi) { f32x2_t v = {lo, hi}; bf16x2_t b = __builtin_convertvector(v, bf16x2_t); return __builtin_bit_cast(unsigned, b); }
__device__ __forceinline__ bf16_t f2bf(float f) { return (bf16_t)(pk2(f, 0.f) & 0xffffu); }
__device__ __forceinline__ float wave_sum(float v) {
#pragma unroll
    for (int o = 1; o < 64; o <<= 1) v += __shfl_xor(v, o);
    return v;
}
__device__ __forceinline__ f32x4 mfma16(bf16x8 x, bf16x8 y, f32x4 acc) { return __builtin_amdgcn_mfma_f32_16x16x32_bf16(x, y, acc, 0, 0, 0); }
__device__ __forceinline__ bf16x8 lfrag(const LAS bf16_t* base, int row, int stride, int col) { return *(const LAS bf16x8*)(base + row * stride + col); }
__device__ __forceinline__ bf16x8 gfrag(const bf16_t* p) { return *(const bf16x8*)p; }
__device__ __forceinline__ float cos_rev(float r) { return __builtin_amdgcn_cosf(r); }
__device__ __forceinline__ float sin_rev(float r) { return __builtin_amdgcn_sinf(r); }
__device__ __forceinline__ float logsig(float x) { return -log1pf(expf(-x)); }
__device__ __forceinline__ float act_f(float v, int act) {
    if (act == 0) return v;
    if (act == 4) { const float r = fmaxf(v, 0.f); return r * r; }
    const float u = (act == 2) ? 1.5957691216057308f * (v + 0.044715f * v * v * v) : v;
    const float s = __builtin_amdgcn_rcpf(1.f + __expf(-u));
    return act == 3 ? s : v * s;
}


#define XB_TMO      128
#define XB_XCNT(j)  (256  + 64 * (j))
#define XB_XSUB(j)  (1280 + 64 * (j))
#define XB_XGEN(j)  (2304 + 64 * (j))
#define XB_TOP      3328
#define XB_TOPGEN   3392
#define XCD_BAR_WORDS 3456
#define XB_SPIN_CAP (1u << 18)
__device__ __forceinline__ unsigned xb_ld(unsigned* p)              { return __hip_atomic_load(p, __ATOMIC_RELAXED, __HIP_MEMORY_SCOPE_AGENT); }
__device__ __forceinline__ unsigned xb_add(unsigned* p, unsigned v) { return __hip_atomic_fetch_add(p, v, __ATOMIC_RELAXED, __HIP_MEMORY_SCOPE_AGENT); }
__device__ __forceinline__ unsigned xb_xcc_id() { return (unsigned)__builtin_amdgcn_s_getreg((3 << 11) | 20) & 0xFu; }
#define XB_SPIN(cond, bar) do { unsigned _sp = 0; while (cond) { __builtin_amdgcn_s_sleep(1); \
    if ((++_sp & 255u) == 0u) { if (xb_ld(&(bar)[XB_TMO])) break; if (_sp > XB_SPIN_CAP) { atomicAdd(&(bar)[XB_TMO], 1u); break; } } } } while (0)
struct XcdBarrier { unsigned* bar; unsigned x; volatile LAS unsigned* st; };
__device__ __forceinline__ XcdBarrier xcd_barrier_post(unsigned* bar, volatile LAS unsigned* st) {
    XcdBarrier b; b.bar = bar; b.x = xb_xcc_id(); b.st = st;
    if (threadIdx.x == 0) (void)xb_add(&bar[XB_XCNT(b.x)], 1u);
    return b;
}
__device__ __forceinline__ void xcd_barrier_complete(unsigned* bar, unsigned x, unsigned& nloc, unsigned& nx) {
    const unsigned G = gridDim.x * gridDim.y * gridDim.z;
    unsigned sum, cnt, mine, sp = 0u;
    for (;;) {
        sum = 0u; cnt = 0u; mine = 0u;
#pragma unroll
        for (unsigned j = 0; j < 16; ++j) { const unsigned c = xb_ld(&bar[XB_XCNT(j)]); sum += c; cnt += (c > 0u) ? 1u : 0u; mine = (j == x) ? c : mine; }
        if (sum == G) break;
        __builtin_amdgcn_s_sleep(1);
        if ((++sp & 255u) == 0u) { if (xb_ld(&bar[XB_TMO])) break; if (sp > XB_SPIN_CAP) { atomicAdd(&bar[XB_TMO], 1u); break; } }
    }
    nloc = mine > 0u ? mine : 1u; nx = cnt > 0u ? cnt : 1u;
}
__device__ __forceinline__ void xcd_barrier(const XcdBarrier& b) {
    asm volatile("s_waitcnt vmcnt(0)" ::: "memory");
    __syncthreads();
    if (threadIdx.x == 0) {
        unsigned* bar = b.bar;
        __builtin_amdgcn_s_waitcnt(0);
        unsigned nloc = b.st[0], nx = b.st[1];
        if (nloc == 0u) { xcd_barrier_complete(bar, b.x, nloc, nx); b.st[0] = nloc; b.st[1] = nx; }
        const unsigned old = xb_add(&bar[XB_XSUB(b.x)], 1u);
        const unsigned gen = old / nloc;
        if (old + 1u == (gen + 1u) * nloc) {
            __builtin_amdgcn_fence(__ATOMIC_RELEASE, "agent");
            asm volatile("s_waitcnt vmcnt(0)" ::: "memory");
            const unsigned og = xb_add(&bar[XB_TOP], 1u);
            const unsigned tg = og / nx;
            if (og + 1u == (tg + 1u) * nx) xb_add(&bar[XB_TOPGEN], 1u);
            else XB_SPIN(xb_ld(&bar[XB_TOPGEN]) == tg, bar);
            __builtin_amdgcn_fence(__ATOMIC_ACQUIRE, "agent");
            xb_add(&bar[XB_XGEN(b.x)], 1u);
            asm volatile("s_waitcnt vmcnt(0)" ::: "memory");
        } else {
            XB_SPIN(xb_ld(&bar[XB_XGEN(b.x)]) == gen, bar);
            __builtin_amdgcn_fence(__ATOMIC_ACQUIRE, "agent");
            asm volatile("s_waitcnt vmcnt(0)" ::: "memory");
        }
    }
    __syncthreads();
}

namespace pg8 {
constexpr int BM = 256, BK = 64, HALF = 128, HTB = HALF * BK * 2, NXCD = 8, WGM = 8;
__host__ __device__ __forceinline__ int lds_byte(int r, int c) { const int st = (r >> 4) * 2 + (c >> 5), rr = r & 15, cc = c & 31, ob = rr * 64 + cc * 2; return st * 1024 + (ob ^ (((ob >> 9) & 1) << 5)); }
__host__ __device__ __forceinline__ void stage_rc(int b, int& R, int& C) { const int st = b / 1024, sb = b % 1024, swz = sb ^ (((sb >> 9) & 1) << 5); R = (st >> 1) * 16 + swz / 64; C = (st & 1) * 32 + (swz % 64) / 2; }
__host__ __device__ __forceinline__ int perm32(int rho) { const int n = rho >> 4, i = rho & 15; return 8 * (i >> 2) + 4 * n + (i & 3); }
struct Unit { int pm, pn; };
struct Gemm { const bf16_t* A; const bf16_t* Bt; int M, N, K, lda; };
struct StaticOrder {
    int nM, nN, nwg, G, c;
    __device__ void init(int M, int N, int G_, int c_) { nM = M / BM; nN = N / BM; nwg = nM * nN; G = G_; c = c_; }
    __device__ bool next(int i, Unit& u) const {
        const long L = (long)i * G + c; if (L >= nwg) return false;
        int wgid = (int)L; { const int q = nwg / NXCD, r = nwg % NXCD, xcd = wgid % NXCD, off = wgid / NXCD; wgid = (xcd < r ? xcd * (q + 1) : r * (q + 1) + (xcd - r) * q) + off; }
        const int nig = WGM * nN, gid = wgid / nig, fm = gid * WGM, gsz = (nM - fm) < WGM ? (nM - fm) : WGM;
        u.pm = fm + ((wgid % nig) % gsz); u.pn = (wgid % nig) / gsz; return true;
    }
};
__device__ __forceinline__ void store_tile(const f32x4 (&acc)[2][2][4][2], bf16_t* base, int ldc, int rowt, int colt, int act, float sc, int wr, int wc, int fr, int fq) {
    const int row0 = rowt + wr * 64 + fr, col0 = colt + wc * 32 + 8 * fq;
#pragma unroll
    for (int ai = 0; ai < 2; ++ai)
#pragma unroll
        for (int m = 0; m < 4; ++m) { bf16_t* rowp = base + (size_t)(row0 + ai * HALF + m * 16) * ldc + col0;
#pragma unroll
            for (int bj = 0; bj < 2; ++bj) { const f32x4 v0 = acc[ai][bj][m][0] * sc, v1 = acc[ai][bj][m][1] * sc;
                u32x4 w; w.x = pk2(act_f(v0[0], act), act_f(v0[1], act)); w.y = pk2(act_f(v0[2], act), act_f(v0[3], act));
                w.z = pk2(act_f(v1[0], act), act_f(v1[1], act)); w.w = pk2(act_f(v1[2], act), act_f(v1[3], act));
                *(u32x4*)(rowp + bj * HALF) = w; } }
}
struct EpiZ1 {
    static constexpr bool PERM = true, HAS_MID = false;
    bf16_t* qkv; bf16_t* zb;
    __device__ __forceinline__ void mid(f32x4 (&)[2][2][4][2], const Unit&, int, int, int, int, int) const {}
    __device__ __forceinline__ void operator()(const f32x4 (&acc)[2][2][4][2], const Unit& u, int wr, int wc, int fr, int fq) const {
        const int pn = u.pn; bf16_t* base; int ldc, colt, act; float sc = 1.f;
        if (pn < 6) { base = qkv; ldc = QKVW; colt = pn * 256; act = 0; if (pn == 2 || pn == 3) sc = 0.08838834764831845f; }
        else { base = zb; ldc = ZBW; colt = (pn - 6) * 256; act = (pn < 8) ? 1 : (pn == 8 ? 0 : 2); }
        store_tile(acc, base, ldc, u.pm * BM, colt, act, sc, wr, wc, fr, fq);
    }
};
struct EpiAct {
    static constexpr bool PERM = true, HAS_MID = false;
    bf16_t* O; int ldc; int act;
    __device__ __forceinline__ void mid(f32x4 (&)[2][2][4][2], const Unit&, int, int, int, int, int) const {}
    __device__ __forceinline__ void operator()(const f32x4 (&acc)[2][2][4][2], const Unit& u, int wr, int wc, int fr, int fq) const {
        store_tile(acc, O, ldc, u.pm * BM, u.pn * BM, act, 1.f, wr, wc, fr, fq);
    }
};
struct EpiGate {
    static constexpr bool PERM = true, HAS_MID = true;
    const bf16_t* gates; bf16_t* O;
    __device__ __forceinline__ void mid(f32x4 (&acc)[2][2][4][2], const Unit& u, int t, int wr, int wc, int fr, int fq) const {
        const int numofs = (t == 8) ? 0 : 1024;
#pragma unroll
        for (int ai = 0; ai < 2; ++ai)
#pragma unroll
            for (int m = 0; m < 4; ++m) { const bf16_t* gp = gates + (size_t)(u.pm * BM + ai * HALF + wr * 64 + m * 16 + fr) * NGW + u.pn * BM + wc * 32 + 8 * fq + numofs;
#pragma unroll
                for (int bj = 0; bj < 2; ++bj) { const u32x4 nv = *(const u32x4*)(gp + bj * HALF), dv = *(const u32x4*)(gp + bj * HALF + 1024);
#pragma unroll
                    for (int e = 0; e < 4; ++e) { const float n0 = bflo(nv[e]), n1 = bfhi(nv[e]), d0 = bflo(dv[e]), d1 = bfhi(dv[e]);
                        acc[ai][bj][m][e >> 1][(e & 1) * 2] *= n0 * __builtin_amdgcn_rcpf(d0); acc[ai][bj][m][e >> 1][(e & 1) * 2 + 1] *= n1 * __builtin_amdgcn_rcpf(d1); } }
                asm volatile("" ::: "memory"); }
    }
    __device__ __forceinline__ void operator()(const f32x4 (&acc)[2][2][4][2], const Unit& u, int wr, int wc, int fr, int fq) const {
        const int row0 = u.pm * BM + wr * 64 + fr, col0 = u.pn * BM + wc * 32 + 8 * fq;
#pragma unroll
        for (int ai = 0; ai < 2; ++ai)
#pragma unroll
            for (int m = 0; m < 4; ++m) { const size_t r = (size_t)(row0 + ai * HALF + m * 16);
#pragma unroll
                for (int bj = 0; bj < 2; ++bj) { const u32x4 gv = *(const u32x4*)(gates + r * NGW + col0 + bj * HALF + 2048);
                    const f32x4 v0 = acc[ai][bj][m][0], v1 = acc[ai][bj][m][1];
                    u32x4 w; w.x = pk2(v0[0] * bflo(gv[0]), v0[1] * bfhi(gv[0])); w.y = pk2(v0[2] * bflo(gv[1]), v0[3] * bfhi(gv[1]));
                    w.z = pk2(v1[0] * bflo(gv[2]), v1[1] * bfhi(gv[2])); w.w = pk2(v1[2] * bflo(gv[3]), v1[3] * bfhi(gv[3]));
                    *(u32x4*)(O + r * D + col0 + bj * HALF) = w; } }
    }
};

template <class Epi>
__device__ __forceinline__ void gemm_phase(LAS unsigned char* lds, const Gemm g, const StaticOrder& S, const Epi& E) {
    int tid = threadIdx.x; asm volatile("" : "+v"(tid));
    const int wid = __builtin_amdgcn_readfirstlane(tid >> 6), lane = tid & 63, wr = wid >> 2, wc = wid & 3, fr = lane & 15, fq = lane >> 4;
    const int K = g.K, nt = K / BK, lda = g.lda;
    unsigned voffA, voffB;
    { int R, C; stage_rc(tid * 16, R, C); const int Rb = Epi::PERM ? ((R & ~31) + perm32(R & 31)) : R;
        voffA = (unsigned)(R * lda + C) * 2u; voffB = (unsigned)(Rb * K + C) * 2u; }
    const size_t sk_voffA = (size_t)64 * lda * 2, sk_voffB = (size_t)64 * K * 2;
    const size_t kstep = (size_t)(BK * 2);
    const size_t hsA = (size_t)HALF * lda * 2, hsB = (size_t)HALF * K * 2, tsA = 2 * hsA, tsB = 2 * hsB;
    const unsigned ldsw = (unsigned)wid * 1024u;
    const int aoff = lds_byte(wr * 64 + fr, fq * 8), boff = lds_byte(wc * 32 + fr, fq * 8);
#define PG8_SA(b, h) (((b) * 2 + (h)) * HTB)
#define PG8_SB(b, h) ((4 + (b) * 2 + (h)) * HTB)
#define PG8_STAGE(bufoff, gbase, voff) do { _Pragma("unroll") for (int _i = 0; _i < 2; ++_i) \
        __builtin_amdgcn_global_load_lds((const unsigned*)((const char*)(gbase) + (size_t)_i * sk_##voff + (voff)), (LAS unsigned*)(lds + (bufoff) + ldsw + _i * 8192), 16, 0, 0); } while (0)
#define PG8_LDA(dst, b, h) do { _Pragma("unroll") for (int m = 0; m < 4; ++m) _Pragma("unroll") for (int k = 0; k < 2; ++k) dst[m][k] = *(const LAS bf16x8*)(lds + PG8_SA(b, h) + aoff + m * 2048 + k * 1024); } while (0)
#define PG8_LDB(dst, b, h) do { _Pragma("unroll") for (int n = 0; n < 2; ++n) _Pragma("unroll") for (int k = 0; k < 2; ++k) dst[n][k] = *(const LAS bf16x8*)(lds + PG8_SB(b, h) + boff + n * 2048 + k * 1024); } while (0)
#define PG8_MMA(ai, bj, At, Bt) do { __builtin_amdgcn_s_setprio(1); _Pragma("unroll") for (int m = 0; m < 4; ++m) _Pragma("unroll") for (int n = 0; n < 2; ++n) _Pragma("unroll") for (int k = 0; k < 2; ++k) \
        acc[ai][bj][m][n] = __builtin_amdgcn_mfma_f32_16x16x32_bf16(Bt[n][k], At[m][k], acc[ai][bj][m][n], 0, 0, 0); __builtin_amdgcn_s_setprio(0); } while (0)
#define PG8_WAIT_V(n) asm volatile("s_waitcnt vmcnt(" #n ")" ::: "memory")
#define PG8_WAIT_L(n) asm volatile("s_waitcnt lgkmcnt(" #n ")" ::: "memory")
#define PG8_BAR __builtin_amdgcn_s_barrier()
#define PG8_SCHED __builtin_amdgcn_sched_barrier(0)
    Unit cur, nxt; int ui = 0;
    if (!S.next(0, cur)) return;
    f32x4 acc[2][2][4][2];
#pragma unroll
    for (int a = 0; a < 2; ++a)
#pragma unroll
        for (int b = 0; b < 2; ++b)
#pragma unroll
            for (int m = 0; m < 4; ++m)
#pragma unroll
                for (int n = 0; n < 2; ++n) acc[a][b][m][n] = (f32x4){0.f, 0.f, 0.f, 0.f};
    bf16x8 At[4][2], B0[2][2], B1[2][2];
    const char* cA = (const char*)g.A + (size_t)cur.pm * tsA; const char* cB = (const char*)g.Bt + (size_t)cur.pn * tsB;
    PG8_STAGE(PG8_SB(0, 0), cB, voffB); PG8_STAGE(PG8_SB(0, 1), cB + hsB, voffB); PG8_STAGE(PG8_SA(0, 0), cA, voffA); PG8_STAGE(PG8_SA(0, 1), cA + hsA, voffA);
    if (wr == 1) PG8_BAR;
    PG8_WAIT_V(2); PG8_BAR;
    PG8_STAGE(PG8_SB(1, 0), cB + kstep, voffB); PG8_STAGE(PG8_SA(1, 0), cA + kstep, voffA); PG8_STAGE(PG8_SB(1, 1), cB + hsB + kstep, voffB);
    PG8_WAIT_V(6); PG8_BAR;
    for (;;) {
        const bool has_next = S.next(ui + 1, nxt);
        const char* nA = has_next ? (const char*)g.A + (size_t)nxt.pm * tsA : cA; const char* nB = has_next ? (const char*)g.Bt + (size_t)nxt.pn * tsB : cB;
        for (int t = 0; t < nt; t += 2) {
            const bool last = (t == nt - 2);
            const char* a1 = cA + (size_t)(t + 1) * kstep;
            const char* a2 = last ? nA : cA + (size_t)(t + 2) * kstep; const char* b2 = last ? nB : cB + (size_t)(t + 2) * kstep;
            const char* a3 = a2 + kstep; const char* b3 = b2 + kstep;
            if constexpr (Epi::HAS_MID) { if (t == 8 || t == 12) E.mid(acc, cur, t, wr, wc, fr, fq); }
            PG8_LDB(B0, 0, 0); PG8_LDB(B1, 0, 1); PG8_SCHED; PG8_LDA(At, 0, 0); PG8_STAGE(PG8_SA(1, 1), a1 + hsA, voffA);
            PG8_WAIT_V(8); PG8_WAIT_L(0); PG8_BAR; PG8_MMA(0, 0, At, B0); PG8_MMA(0, 1, At, B1); PG8_BAR; PG8_SCHED;
            PG8_LDA(At, 0, 1); PG8_STAGE(PG8_SB(0, 0), b2, voffB); PG8_STAGE(PG8_SB(0, 1), b2 + hsB, voffB); PG8_STAGE(PG8_SA(0, 0), a2, voffA);
            PG8_WAIT_V(8); PG8_WAIT_L(0); PG8_BAR; PG8_MMA(1, 0, At, B0); PG8_MMA(1, 1, At, B1); PG8_BAR; PG8_SCHED;
            PG8_LDB(B0, 1, 0); PG8_LDB(B1, 1, 1); PG8_SCHED; PG8_LDA(At, 1, 0); PG8_STAGE(PG8_SA(0, 1), a2 + hsA, voffA);
            PG8_WAIT_V(8); PG8_WAIT_L(0); PG8_BAR; PG8_MMA(0, 0, At, B0); PG8_MMA(0, 1, At, B1); PG8_BAR; PG8_SCHED;
            PG8_LDA(At, 1, 1); PG8_STAGE(PG8_SB(1, 0), b3, voffB); PG8_STAGE(PG8_SB(1, 1), b3 + hsB, voffB); PG8_STAGE(PG8_SA(1, 0), a3, voffA);
            PG8_WAIT_V(8); PG8_WAIT_L(0); PG8_BAR; PG8_MMA(1, 0, At, B0); PG8_MMA(1, 1, At, B1); PG8_BAR; PG8_SCHED;
        }
        if (wr == 0) PG8_BAR;
        E(acc, cur, wr, wc, fr, fq);
        if (!has_next) break;
#pragma unroll
        for (int a = 0; a < 2; ++a)
#pragma unroll
            for (int b = 0; b < 2; ++b)
#pragma unroll
                for (int m = 0; m < 4; ++m)
#pragma unroll
                    for (int n = 0; n < 2; ++n) acc[a][b][m][n] = (f32x4){0.f, 0.f, 0.f, 0.f};
        cur = nxt; cA = nA; cB = nB; ++ui;
        if (wr == 1) PG8_BAR;
    }
    PG8_WAIT_V(0);
    PG8_BAR;
#undef PG8_SA
#undef PG8_SB
#undef PG8_STAGE
#undef PG8_LDA
#undef PG8_LDB
#undef PG8_MMA
#undef PG8_WAIT_V
#undef PG8_WAIT_L
#undef PG8_BAR
#undef PG8_SCHED
}
}


template <int MODE, int NC>
__device__ __forceinline__ void small_gemm_unit(LAS unsigned char* L, const bf16_t* A, int lda, const bf16_t* Bt, int K, bf16_t* O, int ldc, const bf16_t* gates, int unit, int nNu, int tid) {
    asm volatile("" : "+v"(tid));
    constexpr int SK = (NC == 1) ? 8 : 4, NT = 2 * NC;
    const int w = tid >> 6, lane = tid & 63, fr = lane & 15, fq = lane >> 4, wm = w & 1, wk = w >> 1;
    const int rt = unit / nNu, ct = unit - rt * nNu;
    const int r0 = rt * 64 + wm * 32, n0 = ct * 32 * NC, kq = K >> 2;
    f32x4 acc[2][NT];
#pragma unroll
    for (int a = 0; a < 2; ++a)
#pragma unroll
        for (int b = 0; b < NT; ++b) acc[a][b] = (f32x4){0.f, 0.f, 0.f, 0.f};
    const bf16_t* ap = A + (size_t)(r0 + fr) * lda + wk * kq + fq * 8;
    const bf16_t* bp = Bt + (size_t)(n0 + fr) * K + wk * kq + fq * 8;
#pragma unroll 1
    for (int k0 = 0; k0 < kq; k0 += 32 * SK) {
        bf16x8 af[SK][2], bfr[SK][NT];
#pragma unroll
        for (int s = 0; s < SK; ++s) { af[s][0] = gfrag(ap + k0 + s * 32); af[s][1] = gfrag(ap + (size_t)16 * lda + k0 + s * 32);
#pragma unroll
            for (int nj = 0; nj < NT; ++nj) bfr[s][nj] = gfrag(bp + (size_t)(16 * nj) * K + k0 + s * 32); }
#pragma unroll
        for (int s = 0; s < SK; ++s)
#pragma unroll
            for (int mi = 0; mi < 2; ++mi)
#pragma unroll
                for (int nj = 0; nj < NT; ++nj) acc[mi][nj] = mfma16(bfr[s][nj], af[s][mi], acc[mi][nj]);
    }
    LAS f32x4* red = (LAS f32x4*)L;
#pragma unroll
    for (int t = 0; t < 2 * NT; ++t) red[((wk * 2 + wm) * (2 * NT) + t) * 64 + lane] = acc[t / NT][t % NT];
    __syncthreads();
#pragma unroll
    for (int i = 0; i < NC; ++i) { const int t = wk + 4 * i, mi = t / NT, nj = t % NT;
      f32x4 p[4];
#pragma unroll
      for (int q = 0; q < 4; ++q) p[q] = red[((q * 2 + wm) * (2 * NT) + t) * 64 + lane];
      const int row = r0 + mi * 16 + fr, col = n0 + nj * 16 + 4 * fq;
      f32x4 v;
      if (MODE == 5) { const bf16_t* gp = gates + (size_t)row * NGW + col; const u32x2 ga = *(const u32x2*)gp, gb = *(const u32x2*)(gp + 1024), gc = *(const u32x2*)(gp + 2048);
          const f32x4 fa = {bflo(ga.x), bfhi(ga.x), bflo(ga.y), bfhi(ga.y)}, fb = {bflo(gb.x), bfhi(gb.x), bflo(gb.y), bfhi(gb.y)}, fc = {bflo(gc.x), bfhi(gc.x), bflo(gc.y), bfhi(gc.y)};
          v = fa * (p[0] + p[1]) + fb * p[2] + fc * p[3]; }
      else { v = (p[0] + p[1]) + (p[2] + p[3]);
#pragma unroll
          for (int e = 0; e < 4; ++e) v[e] = act_f(v[e], MODE); }
      u32x2 o; o.x = pk2(v[0], v[1]); o.y = pk2(v[2], v[3]);
      *(u32x2*)(O + (size_t)row * ldc + col) = o; }
    __syncthreads();
}

__device__ __forceinline__ void tr_item(const float* W, int N, bf16_t* WT, int ldk, int kofs, LAS float* scr, int item, int lane) {
    const int nblk = N / 32, kb = item / nblk, nb = item % nblk, k0 = 64 * kb, n0 = 32 * nb;
#pragma unroll 8
    for (int i = 0; i < 32; ++i) { const int kk = 2 * i + (lane >> 5); scr[kk * 33 + (lane & 31)] = W[(size_t)(k0 + kk) * N + n0 + (lane & 31)]; }
    asm volatile("s_waitcnt lgkmcnt(0)" ::: "memory");
    const int c = lane & 7;
#pragma unroll
    for (int j = 0; j < 4; ++j) { const int n = (lane >> 3) + 8 * j; const LAS float* s = scr + (8 * c) * 33 + n;
        u32x4 o; o.x = pk2(s[0 * 33], s[1 * 33]); o.y = pk2(s[2 * 33], s[3 * 33]); o.z = pk2(s[4 * 33], s[5 * 33]); o.w = pk2(s[6 * 33], s[7 * 33]);
        *(u32x4*)(WT + (size_t)(n0 + n) * ldk + kofs + k0 + 8 * c) = o; }
    asm volatile("s_waitcnt lgkmcnt(0)" ::: "memory");
}

__device__ __forceinline__ void modnorm_store(const f32x4 (&v)[4], const float* gain, const float* sc, const float* sh, bf16_t* orow, int lane) {
    float ss = 0.f;
#pragma unroll
    for (int j = 0; j < 4; ++j) ss += (v[j].x * v[j].x + v[j].y * v[j].y) + (v[j].z * v[j].z + v[j].w * v[j].w);
    const float rstd = 1.0f / sqrtf(wave_sum(ss) * (1.f / D) + EPS);
#pragma unroll
    for (int j = 0; j < 4; ++j) { const int col = 4 * lane + 256 * j;
        const f32x4 g = *(const f32x4*)(gain + col), s1 = *(const f32x4*)(sc + col), s0 = *(const f32x4*)(sh + col);
        const f32x4 h = v[j] * rstd * g * (s1 + 1.0f) + s0;
        u32x2 w; w.x = pk2(h.x, h.y); w.y = pk2(h.z, h.w); *(u32x2*)(orow + col) = w; }
}
__device__ __forceinline__ void row_update(const bf16_t* yrow, const float* xrow, float* xdst, const float* gpost, const float* gate,
                                           const float* gpre, const float* sc, const float* sh, bf16_t* hrow, int lane) {
    f32x4 y[4], x[4]; float ss = 0.f;
#pragma unroll
    for (int j = 0; j < 4; ++j) { const int col = 4 * lane + 256 * j; const u32x2 w = *(const u32x2*)(yrow + col);
        y[j] = (f32x4){bflo(w.x), bfhi(w.x), bflo(w.y), bfhi(w.y)}; x[j] = *(const f32x4*)(xrow + col);
        ss += (y[j].x * y[j].x + y[j].y * y[j].y) + (y[j].z * y[j].z + y[j].w * y[j].w); }
    const float rstd = 1.0f / sqrtf(wave_sum(ss) * (1.f / D) + EPS);
#pragma unroll
    for (int j = 0; j < 4; ++j) { const int col = 4 * lane + 256 * j;
        const f32x4 g = *(const f32x4*)(gpost + col), gt = *(const f32x4*)(gate + col);
        x[j] = x[j] + gt * (y[j] * rstd * g);
#ifdef DBG_SANITIZE
        if (!hrow) { for (int e = 0; e < 4; ++e) if (!(fabsf(x[j][e]) < 1e30f)) x[j][e] = 12345.f; }
#endif
        *(f32x4*)(xdst + col) = x[j]; }
    if (hrow) modnorm_store(x, gpre, sc, sh, hrow, lane);
}

constexpr int LP = 136;
constexpr int LP64 = 72;
constexpr int LPC = 264;
constexpr int TBL_OFF = 106496;

__device__ __forceinline__ int chunk_row0(int ch) { return ch < 128 ? ch * 128 : ML + (ch - 128) * 128; }

__device__ __forceinline__ void unit_rb(LAS unsigned char* L, bf16_t* qkv, bf16_t* su, const float* dlog, int ch, int h, int tid) {
    asm volatile("" : "+v"(tid));
    const bool latent = ch < 128; const int r0 = chunk_row0(ch);
    const float lgf = logsig(dlog[h]), lgb = logsig(dlog[4 + h]);
    LAS bf16_t* KT = (LAS bf16_t*)L; LAS bf16_t* VfT = KT + 128 * LP; LAS bf16_t* VbT = VfT + 128 * LP;
    u32x4 gk[2][2], gq[2][2], gv[4];
#pragma unroll
    for (int it = 0; it < 2; ++it) { const int item = it * NTHR + tid, c = item & 127, d0 = (item >> 7) * 8;
        const bf16_t* rowp = qkv + (size_t)(r0 + c) * QKVW + h * 128 + d0;
        gk[it][0] = *(const u32x4*)(rowp + 512); gk[it][1] = *(const u32x4*)(rowp + 512 + 64);
        if (latent) { gq[it][0] = *(const u32x4*)(rowp); gq[it][1] = *(const u32x4*)(rowp + 64); } else { gq[it][0] = gk[it][0]; gq[it][1] = gk[it][1]; } }
#pragma unroll
    for (int it = 0; it < 4; ++it) { const int item = it * NTHR + tid; gv[it] = *(const u32x4*)(qkv + (size_t)(r0 + (item & 127)) * QKVW + 1024 + h * 128 + (item >> 7) * 8); }
#pragma unroll
    for (int it = 0; it < 2; ++it) {
        const int item = it * NTHR + tid, c = item & 127, dg = item >> 7, d0 = dg * 8;
        bf16_t* rowp = qkv + (size_t)(r0 + c) * QKVW + h * 128 + d0;
        float cs[8], sn[8];
        if (latent) { const int t = (r0 + c) & (SEQ - 1); const float pos = (dg < 4) ? (float)(t >> 6) : (float)(t & 63);
#pragma unroll
            for (int i = 0; i < 8; ++i) { const int jj = (d0 + i) & 31; float rev = pos * __builtin_amdgcn_exp2f(-(float)jj * 0.41524101186092f) * 0.15915494309189535f;
                rev = rev - floorf(rev); cs[i] = cos_rev(rev); sn[i] = sin_rev(rev); } }
        else {
#pragma unroll
            for (int i = 0; i < 8; ++i) { cs[i] = 1.f; sn[i] = 0.f; } }
        {
            const u32x4 lo = gk[it][0], hi = gk[it][1];
            u32x4 wl, wh;
#pragma unroll
            for (int e = 0; e < 4; ++e) { const float a0 = bflo(lo[e]), a1 = bfhi(lo[e]), b0 = bflo(hi[e]), b1 = bfhi(hi[e]);
                wl[e] = pk2(a0 * cs[2 * e] - b0 * sn[2 * e], a1 * cs[2 * e + 1] - b1 * sn[2 * e + 1]);
                wh[e] = pk2(a0 * sn[2 * e] + b0 * cs[2 * e], a1 * sn[2 * e + 1] + b1 * cs[2 * e + 1]); }
            if (latent) { *(u32x4*)(rowp + 512) = wl; *(u32x4*)(rowp + 512 + 64) = wh; }
#pragma unroll
            for (int e = 0; e < 4; ++e) { KT[(d0 + 2 * e) * LP + c] = (bf16_t)(wl[e] & 0xffffu); KT[(d0 + 2 * e + 1) * LP + c] = (bf16_t)(wl[e] >> 16);
                KT[(64 + d0 + 2 * e) * LP + c] = (bf16_t)(wh[e] & 0xffffu); KT[(64 + d0 + 2 * e + 1) * LP + c] = (bf16_t)(wh[e] >> 16); }
        }
        if (latent) {
            const u32x4 lo = gq[it][0], hi = gq[it][1];
            u32x4 wl, wh;
#pragma unroll
            for (int e = 0; e < 4; ++e) { const float a0 = bflo(lo[e]), a1 = bfhi(lo[e]), b0 = bflo(hi[e]), b1 = bfhi(hi[e]);
                wl[e] = pk2(a0 * cs[2 * e] - b0 * sn[2 * e], a1 * cs[2 * e + 1] - b1 * sn[2 * e + 1]);
                wh[e] = pk2(a0 * sn[2 * e] + b0 * cs[2 * e], a1 * sn[2 * e + 1] + b1 * cs[2 * e + 1]); }
            *(u32x4*)(rowp) = wl; *(u32x4*)(rowp + 64) = wh;
        }
    }
#pragma unroll
    for (int it = 0; it < 4; ++it) {
        const int item = it * NTHR + tid, c = item & 127, e0 = (item >> 7) * 8;
        const u32x4 vv = gv[it];
        const float wf = __expf(lgf * (float)(127 - c)), wb = __expf(lgb * (float)c);
#pragma unroll
        for (int e = 0; e < 4; ++e) { const float v0 = bflo(vv[e]), v1 = bfhi(vv[e]);
            VfT[(e0 + 2 * e) * LP + c] = f2bf(v0 * wf); VfT[(e0 + 2 * e + 1) * LP + c] = f2bf(v1 * wf);
            VbT[(e0 + 2 * e) * LP + c] = f2bf(v0 * wb); VbT[(e0 + 2 * e + 1) * LP + c] = f2bf(v1 * wb); }
    }
    __syncthreads();
    const int w = tid >> 6, lane = tid & 63, fr = lane & 15, fq = lane >> 4;
    bf16x8 xk[4];
#pragma unroll
    for (int kk = 0; kk < 4; ++kk) xk[kk] = lfrag(KT, 16 * w + fr, LP, kk * 32 + fq * 8);
#pragma unroll
    for (int dir = 0; dir < 2; ++dir) { const LAS bf16_t* VT = dir ? VbT : VfT;
        bf16_t* sp = su + ((size_t)(dir * NCH + ch) * 4 + h) * 16384;
#pragma unroll
        for (int et = 0; et < 8; ++et) { f32x4 a = {0.f, 0.f, 0.f, 0.f};
#pragma unroll
            for (int kk = 0; kk < 4; ++kk) a = mfma16(xk[kk], lfrag(VT, et * 16 + fr, LP, kk * 32 + fq * 8), a);
            u32x2 o; o.x = pk2(a[0], a[1]); o.y = pk2(a[2], a[3]);
            *(u32x2*)(sp + (et * 16 + fr) * 128 + 16 * w + 4 * fq) = o; } }
    __syncthreads();
}

__device__ __forceinline__ void scan_item(unsigned* su32, const float* dlog, int item, int tid) {
    asm volatile("" : "+v"(tid));
    const int combo = item >> 4, b = combo & 1, h = (combo >> 1) & 3, dir = combo >> 3, sub = item & 15;
    const int idx2 = sub * NTHR + tid;
    const float decay = expf(logsig(dlog[dir * 4 + h]) * 128.f);
    float s0 = 0.f, s1 = 0.f;
#pragma unroll 1
    for (int i0 = 0; i0 < 66; i0 += 6) {
        unsigned uv[6]; size_t off[6];
#pragma unroll
        for (int j = 0; j < 6; ++j) { const int i = i0 + j;
            const int ch = (i < 2) ? (128 + 2 * b + (dir ? 1 - i : i)) : (64 * b + (dir ? 63 - (i - 2) : (i - 2)));
            off[j] = (((size_t)(dir * NCH + ch) * 4 + h) * 16384) / 2 + idx2; uv[j] = su32[off[j]]; }
#pragma unroll
        for (int j = 0; j < 6; ++j) { su32[off[j]] = pk2(s0, s1); s0 = decay * s0 + bflo(uv[j]); s1 = decay * s1 + bfhi(uv[j]); }
    }
}

__device__ __forceinline__ void unit_rd(LAS unsigned char* L, const bf16_t* qkv, bf16_t* zb, const bf16_t* su, const float* dlog, int ch, int h, int tid) {
    asm volatile("" : "+v"(tid));
    const int r0 = chunk_row0(ch);
    const float lgf = logsig(dlog[h]), lgb = logsig(dlog[4 + h]);
    const float lgf2 = lgf * 1.4426950408889634f, lgb2 = lgb * 1.4426950408889634f;
    LAS bf16_t* Ks = (LAS bf16_t*)L; LAS bf16_t* VT = Ks + 128 * LP; LAS bf16_t* Ps = VT + 128 * LP;
    const bf16_t* spf = su + ((size_t)(0 * NCH + ch) * 4 + h) * 16384; const bf16_t* spb = su + ((size_t)(1 * NCH + ch) * 4 + h) * 16384;
    u32x4 kreg[4], vreg[4], sfr[4], sbr[4];
#pragma unroll
    for (int it = 0; it < 4; ++it) { const int item = it * NTHR + tid;
        kreg[it] = *(const u32x4*)(qkv + (size_t)(r0 + (item >> 4)) * QKVW + 512 + h * 128 + (item & 15) * 8);
        vreg[it] = *(const u32x4*)(qkv + (size_t)(r0 + (item & 127)) * QKVW + 1024 + h * 128 + (item >> 7) * 8);
        sfr[it] = *(const u32x4*)(spf + (size_t)item * 8); sbr[it] = *(const u32x4*)(spb + (size_t)item * 8); }
    const int w = tid >> 6, lane = tid & 63, fr = lane & 15, fq = lane >> 4, cc = 16 * w + fr;
    bf16x8 qf[4];
#pragma unroll
    for (int kk = 0; kk < 4; ++kk) qf[kk] = gfrag(qkv + (size_t)(r0 + cc) * QKVW + h * 128 + kk * 32 + fq * 8);
#pragma unroll
    for (int it = 0; it < 4; ++it) { const int item = it * NTHR + tid;
        *(LAS u32x4*)(Ks + (item >> 4) * LP + (item & 15) * 8) = kreg[it];
        const int c = item & 127, e0 = (item >> 7) * 8;
#pragma unroll
        for (int e = 0; e < 4; ++e) { VT[(e0 + 2 * e) * LP + c] = (bf16_t)(vreg[it][e] & 0xffffu); VT[(e0 + 2 * e + 1) * LP + c] = (bf16_t)(vreg[it][e] >> 16); } }
    __syncthreads();
#pragma unroll
    for (int st = 0; st < 8; ++st) { f32x4 a = {0.f, 0.f, 0.f, 0.f};
#pragma unroll
        for (int kk = 0; kk < 4; ++kk) a = mfma16(lfrag(Ks, st * 16 + fr, LP, kk * 32 + fq * 8), qf[kk], a);
        float p[4];
#pragma unroll
        for (int r = 0; r < 4; ++r) { const int diff = cc - (st * 16 + 4 * fq + r);
            const float m = diff >= 0 ? __builtin_amdgcn_exp2f(lgf2 * (float)diff) : __builtin_amdgcn_exp2f(-lgb2 * (float)diff); p[r] = a[r] * m; }
        u32x2 o; o.x = pk2(p[0], p[1]); o.y = pk2(p[2], p[3]);
        *(LAS u32x2*)(Ps + cc * LP + st * 16 + 4 * fq) = o; }
    __syncthreads();
#pragma unroll
    for (int it = 0; it < 4; ++it) { const int item = it * NTHR + tid; *(LAS u32x4*)(Ks + (item >> 4) * LP + (item & 15) * 8) = sfr[it]; }
    bf16x8 pf[4];
#pragma unroll
    for (int kk = 0; kk < 4; ++kk) pf[kk] = lfrag(Ps, cc, LP, kk * 32 + fq * 8);
    f32x4 o[8];
#pragma unroll
    for (int et = 0; et < 8; ++et) { o[et] = (f32x4){0.f, 0.f, 0.f, 0.f};
#pragma unroll
        for (int kk = 0; kk < 4; ++kk) o[et] = mfma16(lfrag(VT, et * 16 + fr, LP, kk * 32 + fq * 8), pf[kk], o[et]); }
    __syncthreads();
#pragma unroll
    for (int it = 0; it < 4; ++it) { const int item = it * NTHR + tid; *(LAS u32x4*)(VT + (item >> 4) * LP + (item & 15) * 8) = sbr[it]; }
    { const float qd = __expf(lgf * (float)(cc + 1));
#pragma unroll
      for (int et = 0; et < 8; ++et) { f32x4 a = {0.f, 0.f, 0.f, 0.f};
#pragma unroll
          for (int kk = 0; kk < 4; ++kk) a = mfma16(lfrag(Ks, et * 16 + fr, LP, kk * 32 + fq * 8), qf[kk], a);
          o[et] += a * qd; } }
    __syncthreads();
    { const float qd = __expf(lgb * (float)(128 - cc));
#pragma unroll
      for (int et = 0; et < 8; ++et) { f32x4 a = {0.f, 0.f, 0.f, 0.f};
#pragma unroll
          for (int kk = 0; kk < 4; ++kk) a = mfma16(lfrag(VT, et * 16 + fr, LP, kk * 32 + fq * 8), qf[kk], a);
          o[et] += a * qd; } }
    float ss = 0.f;
#pragma unroll
    for (int et = 0; et < 8; ++et) ss += (o[et][0] * o[et][0] + o[et][1] * o[et][1]) + (o[et][2] * o[et][2] + o[et][3] * o[et][3]);
    ss += __shfl_xor(ss, 16); ss += __shfl_xor(ss, 32);
    const float rstd = 1.0f / sqrtf(ss * (1.f / 128.f) + EPS);
#pragma unroll
    for (int et = 0; et < 8; ++et) { bf16_t* gp = zb + (size_t)(r0 + cc) * ZBW + h * 128 + et * 16 + 4 * fq;
        const u32x2 gv = *(const u32x2*)gp; u32x2 ov;
        ov.x = pk2(o[et][0] * rstd * bflo(gv.x), o[et][1] * rstd * bfhi(gv.x)); ov.y = pk2(o[et][2] * rstd * bflo(gv.y), o[et][3] * rstd * bfhi(gv.y));
        *(u32x2*)gp = ov; }
    __syncthreads();
}

__device__ __forceinline__ void unit_fa(LAS unsigned char* L, const bf16_t* zb, bf16_t* T, int uidx, int tid) {
    asm volatile("" : "+v"(tid));
    const int b = uidx >> 7, g = (uidx >> 5) & 3, l2b = (uidx & 31) * 4;
    const LAS bf16_t* TC = (const LAS bf16_t*)(L + TBL_OFF); const LAS bf16_t* TS = TC + 64 * LP64; const LAS bf16_t* TN = TS + 64 * LP64;
    const int w = tid >> 6, lane = tid & 63, fr = lane & 15, fq = lane >> 4;
    { const int it = w >> 1, jt0 = 2 * (w & 1);
      bf16x8 xf[4][2];
#pragma unroll
      for (int jb = 0; jb < 4; ++jb) { const bf16_t* xp = zb + (size_t)(b * SEQ + 128 * (it * 16 + fr) + l2b + jb) * ZBW + 512 + g * 64 + fq * 8; xf[jb][0] = gfrag(xp); xf[jb][1] = gfrag(xp + 32); }
#pragma unroll
      for (int jb = 0; jb < 4; ++jb) { LAS bf16_t* ZrT = (LAS bf16_t*)L + jb * 2 * 64 * LP64; LAS bf16_t* ZiT = ZrT + 64 * LP64;
#pragma unroll
        for (int jj = 0; jj < 2; ++jj) { const int jt = jt0 + jj; f32x4 zr = {0.f, 0.f, 0.f, 0.f}, zi = {0.f, 0.f, 0.f, 0.f};
#pragma unroll
          for (int kk = 0; kk < 2; ++kk) { zr = mfma16(xf[jb][kk], lfrag(TC, jt * 16 + fr, LP64, kk * 32 + fq * 8), zr); zi = mfma16(xf[jb][kk], lfrag(TN, jt * 16 + fr, LP64, kk * 32 + fq * 8), zi); }
          u32x2 o; o.x = pk2(zr[0], zr[1]); o.y = pk2(zr[2], zr[3]); *(LAS u32x2*)(ZrT + (jt * 16 + fr) * LP64 + it * 16 + 4 * fq) = o;
          o.x = pk2(zi[0], zi[1]); o.y = pk2(zi[2], zi[3]); *(LAS u32x2*)(ZiT + (jt * 16 + fr) * LP64 + it * 16 + 4 * fq) = o; } } }
    __syncthreads();
    { const int ct = w >> 1, kt0 = 2 * (w & 1);
#pragma unroll
      for (int jb = 0; jb < 4; ++jb) { const LAS bf16_t* ZrT = (const LAS bf16_t*)L + jb * 2 * 64 * LP64; const LAS bf16_t* ZiT = ZrT + 64 * LP64; const int l2 = l2b + jb;
        bf16x8 xr[2], xi[2];
#pragma unroll
        for (int kk = 0; kk < 2; ++kk) { xr[kk] = lfrag(ZrT, ct * 16 + fr, LP64, kk * 32 + fq * 8); xi[kk] = lfrag(ZiT, ct * 16 + fr, LP64, kk * 32 + fq * 8); }
#pragma unroll
        for (int jj = 0; jj < 2; ++jj) { const int kt = kt0 + jj; f32x4 ar = {0.f, 0.f, 0.f, 0.f}, ai = {0.f, 0.f, 0.f, 0.f};
#pragma unroll
          for (int kk = 0; kk < 2; ++kk) { const bf16x8 yc = lfrag(TC, kt * 16 + fr, LP64, kk * 32 + fq * 8), ys = lfrag(TS, kt * 16 + fr, LP64, kk * 32 + fq * 8), yn = lfrag(TN, kt * 16 + fr, LP64, kk * 32 + fq * 8);
              ar = mfma16(xr[kk], yc, ar); ar = mfma16(xi[kk], ys, ar); ai = mfma16(xi[kk], yc, ai); ai = mfma16(xr[kk], yn, ai); }
          const int k1 = kt * 16 + fr; const float fv = (float)((l2 * k1) & 8191) * (1.f / 8192.f); const float tc = cos_rev(fv), ts = sin_rev(fv);
          bf16_t* tp = T + ((size_t)((b * 4 + g) * 128 + l2) * 64 + k1) * 128 + ct * 16 + 4 * fq;
          u32x2 o; o.x = pk2(ar[0] * tc + ai[0] * ts, ar[1] * tc + ai[1] * ts); o.y = pk2(ar[2] * tc + ai[2] * ts, ar[3] * tc + ai[3] * ts); *(u32x2*)tp = o;
          o.x = pk2(ai[0] * tc - ar[0] * ts, ai[1] * tc - ar[1] * ts); o.y = pk2(ai[2] * tc - ar[2] * ts, ai[3] * tc - ar[3] * ts); *(u32x2*)(tp + 64) = o; } } }
    __syncthreads();
}

__device__ __forceinline__ void unit_fb(LAS unsigned char* L, bf16_t* zb, const bf16_t* T, int uidx, int tid) {
    asm volatile("" : "+v"(tid));
    const int b = uidx >> 8, g = (uidx >> 6) & 3, k1 = uidx & 63;
    const LAS bf16_t* Wc = (const LAS bf16_t*)L; const LAS bf16_t* Ws = Wc + 128 * LP;
    LAS bf16_t* ArT = (LAS bf16_t*)L + 2 * 128 * LP; LAS bf16_t* AiT = ArT + 64 * LP;
#pragma unroll
    for (int it = 0; it < 4; ++it) { const int item = it * NTHR + tid, l2 = item >> 4, ck = item & 15;
        const u32x4 vv = *(const u32x4*)(T + ((size_t)((b * 4 + g) * 128 + l2) * 64 + k1) * 128 + ck * 8);
        LAS bf16_t* dst = (ck < 8) ? ArT : AiT; const int c0 = (ck & 7) * 8;
#pragma unroll
        for (int e = 0; e < 4; ++e) { dst[(c0 + 2 * e) * LP + l2] = (bf16_t)(vv[e] & 0xffffu); dst[(c0 + 2 * e + 1) * LP + l2] = (bf16_t)(vv[e] >> 16); } }
    __syncthreads();
    const int w = tid >> 6, lane = tid & 63, fr = lane & 15, fq = lane >> 4;
    bf16x8 yc[4], ys[4];
#pragma unroll
    for (int kk = 0; kk < 4; ++kk) { yc[kk] = lfrag(Wc, 16 * w + fr, LP, kk * 32 + fq * 8); ys[kk] = lfrag(Ws, 16 * w + fr, LP, kk * 32 + fq * 8); }
    const size_t row = (size_t)(b * SEQ + k1 + 64 * (16 * w + fr));
#pragma unroll
    for (int it = 0; it < 4; ++it) { f32x4 a = {0.f, 0.f, 0.f, 0.f};
#pragma unroll
        for (int kk = 0; kk < 4; ++kk) { a = mfma16(lfrag(ArT, it * 16 + fr, LP, kk * 32 + fq * 8), yc[kk], a); a = mfma16(lfrag(AiT, it * 16 + fr, LP, kk * 32 + fq * 8), ys[kk], a); }
        const float sc = 0.0013810679320049757f;
        u32x2 o; o.x = pk2(a[0] * sc, a[1] * sc); o.y = pk2(a[2] * sc, a[3] * sc);
        *(u32x2*)(zb + row * ZBW + 512 + g * 64 + it * 16 + 4 * fq) = o; }
    __syncthreads();
}

__device__ __forceinline__ void unit_fc(LAS unsigned char* L, bf16_t* zb, int uidx, int tid) {
    asm volatile("" : "+v"(tid));
    const int b = uidx >> 2, g = uidx & 3, rb = ML + b * CTXL;
    const LAS bf16_t* TC = (const LAS bf16_t*)(L + TBL_OFF); const LAS bf16_t* TN = TC + 2 * 64 * LP64;
    LAS bf16_t* ZrT = (LAS bf16_t*)L; LAS bf16_t* ZiT = ZrT + 64 * LPC;
    const int w = tid >> 6, lane = tid & 63, fr = lane & 15, fq = lane >> 4;
#pragma unroll
    for (int ii = 0; ii < 2; ++ii) { const int it = 2 * w + ii;
        const bf16_t* xp = zb + (size_t)(rb + it * 16 + fr) * ZBW + 512 + g * 64 + fq * 8;
        bf16x8 xf[2]; xf[0] = gfrag(xp); xf[1] = gfrag(xp + 32);
#pragma unroll
        for (int jt = 0; jt < 4; ++jt) { f32x4 zr = {0.f, 0.f, 0.f, 0.f}, zi = {0.f, 0.f, 0.f, 0.f};
#pragma unroll
            for (int kk = 0; kk < 2; ++kk) { zr = mfma16(xf[kk], lfrag(TC, jt * 16 + fr, LP64, kk * 32 + fq * 8), zr); zi = mfma16(xf[kk], lfrag(TN, jt * 16 + fr, LP64, kk * 32 + fq * 8), zi); }
            u32x2 o; o.x = pk2(zr[0], zr[1]); o.y = pk2(zr[2], zr[3]); *(LAS u32x2*)(ZrT + (jt * 16 + fr) * LPC + it * 16 + 4 * fq) = o;
            o.x = pk2(zi[0], zi[1]); o.y = pk2(zi[2], zi[3]); *(LAS u32x2*)(ZiT + (jt * 16 + fr) * LPC + it * 16 + 4 * fq) = o; } }
    __syncthreads();
#pragma unroll 1
    for (int ii = 0; ii < 2; ++ii) { const int lp = (2 * w + ii) * 16 + fr;
        f32x4 a[4];
#pragma unroll
        for (int i2 = 0; i2 < 4; ++i2) a[i2] = (f32x4){0.f, 0.f, 0.f, 0.f};
#pragma unroll 1
        for (int kk = 0; kk < 8; ++kk) { u32x4 cw, sw;
#pragma unroll
            for (int e = 0; e < 4; ++e) { const int l0 = kk * 32 + fq * 8 + 2 * e; const float f0 = (float)((l0 * lp) & 255) * (1.f / 256.f), f1 = (float)(((l0 + 1) * lp) & 255) * (1.f / 256.f);
                cw[e] = pk2(cos_rev(f0), cos_rev(f1)); sw[e] = pk2(sin_rev(f0), sin_rev(f1)); }
            const bf16x8 yc = __builtin_bit_cast(bf16x8, cw), ys = __builtin_bit_cast(bf16x8, sw);
#pragma unroll
            for (int i2 = 0; i2 < 4; ++i2) { a[i2] = mfma16(lfrag(ZrT, i2 * 16 + fr, LPC, kk * 32 + fq * 8), yc, a[i2]); a[i2] = mfma16(lfrag(ZiT, i2 * 16 + fr, LPC, kk * 32 + fq * 8), ys, a[i2]); } }
#pragma unroll
        for (int i2 = 0; i2 < 4; ++i2) { u32x2 o; o.x = pk2(a[i2][0] * 0.0078125f, a[i2][1] * 0.0078125f); o.y = pk2(a[i2][2] * 0.0078125f, a[i2][3] * 0.0078125f);
            *(u32x2*)(zb + (size_t)(rb + lp) * ZBW + 512 + g * 64 + i2 * 16 + 4 * fq) = o; } }
    __syncthreads();
}

__device__ __forceinline__ void unit_sgu(LAS unsigned char* L, bf16_t* zb, const float* ws, const float* bs, const float* gn, int ch, int g, int tid) {
    asm volatile("" : "+v"(tid));
    const int r0 = chunk_row0(ch);
    LAS bf16_t* VT = (LAS bf16_t*)L;
#pragma unroll
    for (int it = 0; it < 2; ++it) { const int item = it * NTHR + tid, row = item >> 3, ck = item & 7;
        const u32x4 vv = *(const u32x4*)(zb + (size_t)(r0 + row) * ZBW + 1024 + g * 64 + ck * 8);
        float f[8]; float ss = 0.f;
#pragma unroll
        for (int e = 0; e < 4; ++e) { f[2 * e] = bflo(vv[e]); f[2 * e + 1] = bfhi(vv[e]); ss += f[2 * e] * f[2 * e] + f[2 * e + 1] * f[2 * e + 1]; }
        ss += __shfl_xor(ss, 1); ss += __shfl_xor(ss, 2); ss += __shfl_xor(ss, 4);
        const float rstd = 1.0f / sqrtf(ss * (1.f / 64.f) + EPS);
#pragma unroll
        for (int i = 0; i < 8; ++i) VT[(ck * 8 + i) * LP + row] = f2bf(f[i] * rstd * gn[g * 64 + ck * 8 + i]); }
    __syncthreads();
    const int w = tid >> 6, lane = tid & 63, fr = lane & 15, fq = lane >> 4, t = 16 * w + fr;
    bf16x8 yw[4];
#pragma unroll
    for (int kk = 0; kk < 4; ++kk) { const float* wp = ws + (size_t)(g * 128 + t) * 128 + kk * 32 + fq * 8; const f32x4 a = *(const f32x4*)wp, b = *(const f32x4*)(wp + 4);
        u32x4 pw; pw.x = pk2(a.x, a.y); pw.y = pk2(a.z, a.w); pw.z = pk2(b.x, b.y); pw.w = pk2(b.z, b.w); yw[kk] = __builtin_bit_cast(bf16x8, pw); }
    const float bias = bs[g * 128 + t];
#pragma unroll
    for (int it = 0; it < 4; ++it) { f32x4 a = {0.f, 0.f, 0.f, 0.f};
#pragma unroll
        for (int kk = 0; kk < 4; ++kk) a = mfma16(lfrag(VT, it * 16 + fr, LP, kk * 32 + fq * 8), yw[kk], a);
        bf16_t* up = zb + (size_t)(r0 + t) * ZBW + 768 + g * 64 + it * 16 + 4 * fq;
        const u32x2 uv = *(const u32x2*)up; u32x2 o;
        o.x = pk2(bflo(uv.x) * (a[0] + bias), bfhi(uv.x) * (a[1] + bias)); o.y = pk2(bflo(uv.y) * (a[2] + bias), bfhi(uv.y) * (a[3] + bias));
        *(u32x2*)up = o; }
    __syncthreads();
}


#ifdef DBG_NANSCAN
__device__ __forceinline__ bool dbg_scan_rg(const unsigned char* base, size_t bytes, bool f32, int gtid, int gn) {
    const unsigned* p = (const unsigned*)base; const size_t n = bytes / 4; bool bad = false;
    for (size_t i = gtid; i < n; i += gn) { const unsigned v = p[i]; if (f32) { if ((v & 0x7F800000u) == 0x7F800000u) bad = true; } else if ((v & 0x7F80u) == 0x7F80u || (v & 0x7F800000u) == 0x7F800000u) bad = true; }
    return bad;
}
__device__ __forceinline__ bool dbg_huge_rg(const unsigned char* base, size_t bytes, bool f32, int gtid, int gn) {
    const unsigned* p = (const unsigned*)base; const size_t n = bytes / 4; bool bad = false;
    for (size_t i = gtid; i < n; i += gn) { const unsigned v = p[i]; if ((v & 0x7F800000u) >= 0x44800000u) bad = true; if (!f32 && (v & 0x7F80u) >= 0x4480u) bad = true; }
    return bad;
}
__device__ __forceinline__ void dbg_scan(unsigned char* ws, int code, int k0only, int gtid, int gn) {
    unsigned* flag = (unsigned*)ws; bool bad = false;
    { unsigned m = 0;
      if (code == 0) { if (dbg_huge_rg(ws + WS_MOD, 147456, true, gtid, gn)) m |= 1u; if (dbg_huge_rg(ws + WS_W, WS_HN - WS_W, false, gtid, gn)) m |= 2u; }
      if (code == 1) { if (dbg_huge_rg(ws + WS_HN, (size_t)MT * D * 2, false, gtid, gn)) m |= 4u; }
      if (code == 2) { if (dbg_huge_rg(ws + WS_BIG, BIG_SU, false, gtid, gn)) m |= 8u; if (dbg_huge_rg(ws + WS_ZB, (size_t)MT * ZBW * 2, false, gtid, gn)) m |= 16u; }
      if (m) atomicOr(flag + 1, m); }
    const int ph = code < 2 ? code : 2 + (code - 2) % 11;
    const size_t HNB = (size_t)MT * D * 2, ZBB = (size_t)MT * ZBW * 2, BIGB = (size_t)MT * NGW * 2;
    if (ph == 0) { bad |= dbg_scan_rg(ws + WS_MOD, 147456, true, gtid, gn); bad |= dbg_scan_rg(ws + WS_W, WS_HN - WS_W, false, gtid, gn); }
    else if (ph == 1 || ph == 7 || ph == 9 || ph == 11 || ph == 12) bad |= dbg_scan_rg(ws + WS_HN, HNB, false, gtid, gn);
    else if (ph == 2) { bad |= dbg_scan_rg(ws + WS_ZB, ZBB, false, gtid, gn); bad |= dbg_scan_rg(ws + WS_BIG, BIG_SU, false, gtid, gn); }
    else if (ph == 3) { unsigned m = 0;
        if (dbg_scan_rg(ws + WS_ZB, (size_t)ML * ZBW * 2, false, gtid, gn)) m |= 1u;
        if (dbg_scan_rg(ws + WS_ZB + (size_t)ML * ZBW * 2, (size_t)MC * ZBW * 2, false, gtid, gn)) m |= 2u;
        if (dbg_scan_rg(ws + WS_BIG, BIG_SU, false, gtid, gn)) m |= 4u;
        if (dbg_scan_rg(ws + WS_BIG + BIG_SU, BIG_T - BIG_SU, false, gtid, gn)) m |= 8u;
        if (dbg_scan_rg(ws + WS_BIG + BIG_T, 16777216, false, gtid, gn)) m |= 16u;
        bad = m != 0; }
    else if (ph == 4) { bad |= dbg_scan_rg(ws + WS_ZB, ZBB, false, gtid, gn); bad |= dbg_scan_rg(ws + WS_BIG + BIG_SU, BIG_T - BIG_SU, false, gtid, gn); }
    else if (ph == 5) bad |= dbg_scan_rg(ws + WS_ZB, ZBB, false, gtid, gn);
    else if (ph == 6) bad |= dbg_scan_rg(ws + WS_BIG, BIGB, false, gtid, gn);
    else if (ph == 8) bad |= dbg_scan_rg(ws + WS_BIG, HNB, false, gtid, gn);
    else if (ph == 10) bad |= dbg_scan_rg(ws + WS_ZB, (size_t)MT * FF * 2, false, gtid, gn);
    if (bad) atomicMin(flag, (unsigned)code);
}
#endif
#ifdef PROBE_B
#define PROBE_G2(x) x
#else
#define PROBE_G2(x)
#endif
struct Args { const float* in[21]; float* out; unsigned char* ws; int ph_lo, ph_hi; };
constexpr int NPHASE = 24;

__global__ void __launch_bounds__(NTHR, 2) fwd_kernel(Args args) {
    extern __shared__ __attribute__((aligned(16))) unsigned char lds_raw[];
    LAS unsigned char* L = (LAS unsigned char*)lds_raw;
    cg::grid_group grid = cg::this_grid();
    const int wave = __builtin_amdgcn_readfirstlane((int)threadIdx.x >> 6);
#define FRESH_TID int tid = (int)threadIdx.x; asm volatile("" : "+v"(tid)); const int lane = tid & 63; (void)lane;
    const int G = gridDim.x, bx = blockIdx.x;
    const int gw = bx * NWAVES + wave, NGWV = G * NWAVES;
    unsigned char* ws = args.ws;
    float* MOD = (float*)(ws + WS_MOD); float* CTXS = (float*)(ws + WS_CTXS);
    bf16_t* WB = (bf16_t*)(ws + WS_W); bf16_t* HN = (bf16_t*)(ws + WS_HN); bf16_t* ZB = (bf16_t*)(ws + WS_ZB);
    bf16_t* QKV = (bf16_t*)(ws + WS_BIG + BIG_QKV); bf16_t* SU = (bf16_t*)(ws + WS_BIG + BIG_SU); bf16_t* TT = (bf16_t*)(ws + WS_BIG + BIG_T);
    bf16_t* GATES = (bf16_t*)(ws + WS_BIG); bf16_t* YB = (bf16_t*)(ws + WS_BIG); bf16_t* HID = (bf16_t*)(ws + WS_ZB);
    const float* x_in = args.in[0]; const float* ctx_in = args.in[2]; float* xout = args.out;
    const int lo = args.ph_lo, hi = args.ph_hi;
    volatile LAS unsigned* xst = (volatile LAS unsigned*)(L + LDS_BYTES - 64);
    if (threadIdx.x < 2) xst[threadIdx.x] = 0u;
    __syncthreads();
    XcdBarrier xbar = xcd_barrier_post((unsigned*)(ws + 4096), xst);
    if (hi - lo > 1) grid.sync();
#ifdef DBG_NANSCAN
    if (bx == 0 && threadIdx.x == 0) { __hip_atomic_store((unsigned*)ws, 0xFFFFFFFFu, __ATOMIC_RELAXED, __HIP_MEMORY_SCOPE_AGENT); __hip_atomic_store((unsigned*)ws + 1, 0u, __ATOMIC_RELAXED, __HIP_MEMORY_SCOPE_AGENT); }
#endif
#define PH(k) (lo <= (k) && (k) < hi)
#ifdef DBG_NANSCAN
#define DBGSCAN(k) do { int t_ = (int)threadIdx.x; asm volatile("" : "+v"(t_)); dbg_scan(ws, (k), (k) == 0, bx * NTHR + t_, G * NTHR); } while (0)
#else
#define DBGSCAN(k)
#endif
#define CG_SYNC() do { __builtin_amdgcn_fence(__ATOMIC_RELEASE, "agent"); asm volatile("s_waitcnt vmcnt(0) lgkmcnt(0)" ::: "memory"); grid.sync(); __builtin_amdgcn_fence(__ATOMIC_ACQUIRE, "agent"); asm volatile("s_waitcnt vmcnt(0)" ::: "memory"); } while (0)
#ifdef PROBE_A
#define PROBE_SYNC2(k) xcd_barrier(xbar);
#else
#define PROBE_SYNC2(k)
#endif
#define SEAM(k) do { if (PH(k) && PH((k) + 1)) { xcd_barrier(xbar); PROBE_SYNC2(k) DBGSCAN(k); } } while (0)

    if (PH(0)) {
        FRESH_TID
        if (bx < 192) {
            LAS float* scv = (LAS float*)L;
            LAS float* red = scv + 3 * 1024;
            for (int i = tid; i < 3 * 1024; i += NTHR) { const float c = (i < 2048) ? args.in[1][i] : args.in[3][i - 2048]; scv[i] = c / (1.f + __expf(-c)); }
            __syncthreads();
            for (int it = bx; it < 192; it += G) { const int l = it / 96, n0 = (it % 96) * 64;
                const float* wp = args.in[4] + ((size_t)l * D + wave * 128) * 6144 + n0 + lane;
                float a0 = 0.f, a1 = 0.f, a2 = 0.f;
#pragma unroll 8
                for (int k = 0; k < 128; ++k) { const float wv = wp[(size_t)k * 6144]; const int kk = wave * 128 + k; a0 += scv[kk] * wv; a1 += scv[1024 + kk] * wv; a2 += scv[2048 + kk] * wv; }
                red[(wave * 3 + 0) * 64 + lane] = a0; red[(wave * 3 + 1) * 64 + lane] = a1; red[(wave * 3 + 2) * 64 + lane] = a2;
                __syncthreads();
                if (tid < 192) { const int slot = tid >> 6, n = tid & 63; float s = args.in[5][l * 6144 + n0 + n];
#pragma unroll
                    for (int w8 = 0; w8 < 8; ++w8) s += red[(w8 * 3 + slot) * 64 + n];
                    MOD[(size_t)(l * 3 + slot) * 6144 + n0 + n] = s; }
                __syncthreads(); }
        }
        __syncthreads();
        LAS float* scr = (LAS float*)(L + wave * 8448);
        constexpr int C0 = 2944, C1 = C0 + 256, C2 = C1 + 128, C3 = C2 + 128, C4 = C3 + 512, C5 = C4 + 2048, C6 = C5 + 2048;
        for (int it = gw; it < 2 * C6; it += NGWV) { const int l = it / C6; int r = it % C6; bf16_t* wl = WB + (size_t)l * WL_EL;
            if (r < C0) tr_item(args.in[10] + (size_t)l * D * INW, INW, wl + WL_IN, D, 0, scr, r, lane);
            else if (r < C1) tr_item(args.in[15] + (size_t)l * 512 * D, D, wl + WL_CAT, D, 0, scr, r - C0, lane);
            else if (r < C2) tr_item(args.in[16] + (size_t)l * 256 * D, D, wl + WL_CAT, D, 512, scr, r - C1, lane);
            else if (r < C3) tr_item(args.in[17] + (size_t)l * 256 * D, D, wl + WL_CAT, D, 768, scr, r - C2, lane);
            else if (r < C4) tr_item(args.in[18] + (size_t)l * D * D, D, wl + WL_O, D, 0, scr, r - C3, lane);
            else if (r < C5) tr_item(args.in[19] + (size_t)l * D * FF, FF, wl + WL_UP, D, 0, scr, r - C4, lane);
            else tr_item(args.in[20] + (size_t)l * FF * D, D, wl + WL_DN, FF, 0, scr, r - C5, lane); }
    }
    SEAM(0);
    if (PH(1)) {
        FRESH_TID
        for (int r = gw; r < MT; r += NGWV) { const float* xr = r < ML ? x_in + (size_t)r * D : ctx_in + (size_t)(r - ML) * D;
            const int slot = r < SEQ ? 0 : (r < ML ? 1 : 2); const float* md = MOD + (size_t)slot * 6144;
            f32x4 v[4];
#pragma unroll
            for (int j = 0; j < 4; ++j) v[j] = *(const f32x4*)(xr + 4 * lane + 256 * j);
            modnorm_store(v, args.in[6], md + 1024, md, HN + (size_t)r * D, lane); }
    }
    SEAM(1);

#pragma unroll 1
    for (int l = 0; l < 2; ++l) {
        const int P = 2 + 11 * l; const bool last = (l == 1);
        const bf16_t* wl = WB + (size_t)l * WL_EL;
        const float* dlog = args.in[11] + l * 8;
        const int Mrows = last ? ML : MT;
        if (PH(P + 0)) { pg8::Gemm g{HN, wl + WL_IN, MT, N1W, D, D}; pg8::StaticOrder S; S.init(MT, N1W, G, bx);
            pg8::EpiZ1 E{QKV, ZB}; pg8::gemm_phase<pg8::EpiZ1>(L, g, S, E); PROBE_G2(pg8::gemm_phase<pg8::EpiZ1>(L, g, S, E)); }
        SEAM(P + 0);
        if (PH(P + 1)) {
            FRESH_TID
            { LAS bf16_t* TC = (LAS bf16_t*)(L + TBL_OFF);
              for (int i = tid; i < 4096; i += NTHR) { const int k = i >> 6, n = i & 63; const float fv = (float)((k * n) & 63) * (1.f / 64.f); const float c = cos_rev(fv), s = sin_rev(fv);
                  TC[k * LP64 + n] = f2bf(c); TC[64 * LP64 + k * LP64 + n] = f2bf(s); TC[2 * 64 * LP64 + k * LP64 + n] = f2bf(-s); } }
            __syncthreads();
            const int nRB = NCH * 4, nSG = (last ? 128 : NCH) * 4, nFA = 256, nFC = last ? 0 : 8;
            for (int it = bx; it < nRB + nSG + nFA + nFC; it += G) {
                if (it < nRB) unit_rb(L, QKV, SU, dlog, it >> 2, it & 3, tid);
                else if (it < nRB + nSG) { const int u = it - nRB; unit_sgu(L, ZB, args.in[12] + (size_t)l * 4 * 128 * 128, args.in[13] + l * 512, args.in[14] + l * 256, u >> 2, u & 3, tid); }
                else if (it < nRB + nSG + nFA) unit_fa(L, ZB, TT, it - nRB - nSG, tid);
                else unit_fc(L, ZB, it - nRB - nSG - nFA, tid);
            }
        }
        SEAM(P + 1);
        if (PH(P + 2)) {
            FRESH_TID
            { LAS bf16_t* Wc = (LAS bf16_t*)L;
              for (int i = tid; i < 16384; i += NTHR) { const int k = i >> 7, n = i & 127; const float fv = (float)((k * n) & 127) * (1.f / 128.f);
                  Wc[k * LP + n] = f2bf(cos_rev(fv)); Wc[128 * LP + k * LP + n] = f2bf(sin_rev(fv)); } }
            __syncthreads();
            for (int it = bx; it < 256 + 512; it += G) {
                if (it < 256) scan_item((unsigned*)SU, dlog, it, tid);
                else unit_fb(L, ZB, TT, it - 256, tid);
            }
        }
        SEAM(P + 2);
        if (PH(P + 3)) { FRESH_TID const int nRD = (last ? 128 : NCH) * 4;
            for (int it = bx; it < nRD; it += G) unit_rd(L, QKV, ZB, SU, dlog, it >> 2, it & 3, tid); }
        SEAM(P + 3);
        if (PH(P + 4)) { { pg8::Gemm g{HN, wl + WL_IN + (size_t)N1W * D, ML, NGW, D, D}; pg8::StaticOrder S; S.init(ML, NGW, G, bx);
              pg8::EpiAct E{GATES, NGW, 3}; pg8::gemm_phase<pg8::EpiAct>(L, g, S, E); }
            if (!last) { FRESH_TID for (int u = bx; u < 8 * 32; u += G) small_gemm_unit<3, 3>(L, HN + (size_t)ML * D, D, wl + WL_IN + (size_t)N1W * D, D, GATES + (size_t)ML * NGW, NGW, nullptr, u, 32, tid); } }
        SEAM(P + 4);
        if (PH(P + 5)) { { pg8::Gemm g{ZB, wl + WL_CAT, ML, D, D, ZBW}; pg8::StaticOrder S; S.init(ML, D, G, bx);
              pg8::EpiGate E{GATES, HN}; pg8::gemm_phase<pg8::EpiGate>(L, g, S, E); }
            if (!last) { FRESH_TID for (int u = bx; u < 8 * 32; u += G) small_gemm_unit<5, 1>(L, ZB + (size_t)ML * ZBW, ZBW, wl + WL_CAT, D, HN + (size_t)ML * D, D, GATES + (size_t)ML * NGW, u, 32, tid); } }
        SEAM(P + 5);
        if (PH(P + 6)) { { pg8::Gemm g{HN, wl + WL_O, ML, D, D, D}; pg8::StaticOrder S; S.init(ML, D, G, bx);
              pg8::EpiAct E{YB, D, 0}; pg8::gemm_phase<pg8::EpiAct>(L, g, S, E); }
            if (!last) { FRESH_TID for (int u = bx; u < 8 * 32; u += G) small_gemm_unit<0, 1>(L, HN + (size_t)ML * D, D, wl + WL_O, D, YB + (size_t)ML * D, D, nullptr, u, 32, tid); } }
        SEAM(P + 6);
        if (PH(P + 7)) {
            FRESH_TID
            for (int r = gw; r < Mrows; r += NGWV) { const bool lat = r < ML;
                const float* xs = lat ? (l == 0 ? x_in + (size_t)r * D : xout + (size_t)r * D) : (l == 0 ? ctx_in + (size_t)(r - ML) * D : CTXS + (size_t)(r - ML) * D);
                float* xd = lat ? xout + (size_t)r * D : CTXS + (size_t)(r - ML) * D;
                const int slot = r < SEQ ? 0 : (r < ML ? 1 : 2); const float* md = MOD + (size_t)(l * 3 + slot) * 6144;
                row_update(YB + (size_t)r * D, xs, xd, args.in[7] + l * D, md + 2048, args.in[8] + l * D, md + 4096, md + 3072, HN + (size_t)r * D, lane); }
        }
        SEAM(P + 7);
        if (PH(P + 8)) { { pg8::Gemm g{HN, wl + WL_UP, ML, FF, D, D}; pg8::StaticOrder S; S.init(ML, FF, G, bx);
              pg8::EpiAct E{HID, FF, 4}; pg8::gemm_phase<pg8::EpiAct>(L, g, S, E); }
            if (!last) { FRESH_TID for (int u = bx; u < 8 * 64; u += G) small_gemm_unit<4, 2>(L, HN + (size_t)ML * D, D, wl + WL_UP, D, HID + (size_t)ML * FF, FF, nullptr, u, 64, tid); } }
        SEAM(P + 8);
        if (PH(P + 9)) { { pg8::Gemm g{HID, wl + WL_DN, ML, D, FF, FF}; pg8::StaticOrder S; S.init(ML, D, G, bx);
              pg8::EpiAct E{HN, D, 0}; pg8::gemm_phase<pg8::EpiAct>(L, g, S, E); }
            if (!last) { FRESH_TID for (int u = bx; u < 8 * 32; u += G) small_gemm_unit<0, 1>(L, HID + (size_t)ML * FF, FF, wl + WL_DN, FF, HN + (size_t)ML * D, D, nullptr, u, 32, tid); } }
        SEAM(P + 9);
        if (PH(P + 10)) {
            FRESH_TID
            for (int r = gw; r < Mrows; r += NGWV) { const bool lat = r < ML;
                float* xd = lat ? xout + (size_t)r * D : CTXS + (size_t)(r - ML) * D;
                const int slot = r < SEQ ? 0 : (r < ML ? 1 : 2); const float* md = MOD + (size_t)(l * 3 + slot) * 6144;
                const float* mdn = MOD + (size_t)(3 + slot) * 6144;
                row_update(HN + (size_t)r * D, xd, xd, args.in[9] + l * D, md + 5120, args.in[6] + D, mdn + 1024, mdn, last ? nullptr : HN + (size_t)r * D, lane); }
        }
        if (!last) SEAM(P + 10);
    }
#ifdef DBG_NANSCAN
    DBGSCAN(23);
    __builtin_amdgcn_fence(__ATOMIC_RELEASE, "agent"); asm volatile("s_waitcnt vmcnt(0) lgkmcnt(0)" ::: "memory"); grid.sync(); __builtin_amdgcn_fence(__ATOMIC_ACQUIRE, "agent");
    { const unsigned fl = __hip_atomic_load((unsigned*)ws, __ATOMIC_RELAXED, __HIP_MEMORY_SCOPE_AGENT);
      for (size_t i = (size_t)bx * NTHR + threadIdx.x; i < (size_t)ML * D; i += (size_t)G * NTHR) xout[i] = (i == 0) ? 1000.f * (float)(__hip_atomic_load((unsigned*)ws + 1, __ATOMIC_RELAXED, __HIP_MEMORY_SCOPE_AGENT) + 1u) + 0.f * (float)fl : 0.f; }
#endif
#undef PH
#undef SEAM
#undef FRESH_TID
}

#ifndef MK_PER_PHASE
#define MK_PER_PHASE 0
#endif
extern "C" void kernel_launch(void* const* d_in, const int* in_sizes, int n_in, void* d_out, int out_size, void* d_ws, size_t ws_size, hipStream_t stream) {
    static int grid = 0;
    if (grid == 0) {
        if (n_in != 21 || ws_size < WS_END) { fprintf(stderr, "kernel_launch: unexpected n_in %d / ws_size %zu (need %zu)\n", n_in, ws_size, (size_t)WS_END); grid = -1; return; }
        int dev = 0, cus = 0, per_cu = 0;
        hipGetDevice(&dev); hipDeviceGetAttribute(&cus, hipDeviceAttributeMultiprocessorCount, dev);
        if (hipFuncSetAttribute((const void*)fwd_kernel, hipFuncAttributeMaxDynamicSharedMemorySize, LDS_BYTES) != hipSuccess) { fprintf(stderr, "kernel_launch: hipFuncSetAttribute failed\n"); grid = -1; return; }
        if (hipOccupancyMaxActiveBlocksPerMultiprocessor(&per_cu, (const void*)fwd_kernel, NTHR, LDS_BYTES) != hipSuccess || per_cu < 1) { fprintf(stderr, "kernel_launch: occupancy query failed (%d)\n", per_cu); (void)hipGetLastError(); per_cu = 1; }
        if (per_cu > 1) per_cu = 1;
        grid = cus * per_cu;
    }
    if (grid < 0) return;
    if (hipMemsetAsync(d_ws, 0, 65536, stream) != hipSuccess) { fprintf(stderr, "kernel_launch: memset failed\n"); return; }
    Args a{};
    for (int i = 0; i < 21; ++i) a.in[i] = (const float*)d_in[i];
    a.out = (float*)d_out; a.ws = (unsigned char*)d_ws;
#if MK_PER_PHASE
    for (int p = 0; p < NPHASE; ++p) { a.ph_lo = p; a.ph_hi = p + 1; hipLaunchKernelGGL(fwd_kernel, dim3(grid), dim3(NTHR), LDS_BYTES, stream, a); }
#else
    a.ph_lo = 0; a.ph_hi = NPHASE;
    void* kargs[] = {&a};
    hipError_t e = hipLaunchCooperativeKernel((const void*)fwd_kernel, dim3(grid), dim3(NTHR), kargs, LDS_BYTES, stream);
    if (e != hipSuccess) fprintf(stderr, "kernel_launch: cooperative launch failed: %s (grid %d)\n", hipGetErrorString(e), grid);
#endif
}
```
